# Optimizing an MI355X kernel written in HIP

```python
import math
import jax, jax.numpy as jnp
from jax import lax
import numpy as np

D_MODEL = 2048
BATCH = 4
SEQ = 2048
DEPTH = 1

CHUNK = 64
Q_BLOCK = 128
D_MIX = D_MODEL
DIFF_HEADS = 8
DIFF_WIDTH = D_MIX // 2
DIFF_HEAD_DIM = DIFF_WIDTH // DIFF_HEADS
DIFF_QK_DIM = DIFF_HEAD_DIM // 2
GLA_HEADS = 4
GLA_WIDTH = D_MIX - DIFF_WIDTH
GLA_V_DIM = GLA_WIDTH // GLA_HEADS
GLA_K_DIM = GLA_V_DIM // 2
GLA_GATE_RANK = 16
GLA_GATE_TAU = 16.0
ROPE_THETA = 10000.0
NORM_EPS = 1e-6

IN_SPLITS = [
    DIFF_WIDTH,
    DIFF_WIDTH,
    DIFF_WIDTH,
    DIFF_WIDTH,
    GLA_HEADS * GLA_K_DIM,
    GLA_HEADS * GLA_K_DIM,
    GLA_WIDTH,
    GLA_WIDTH,
    GLA_GATE_RANK,
]
D_IN_PROJ = int(sum(IN_SPLITS))
IN_OFFSETS = [int(o) for o in np.cumsum(IN_SPLITS)[:-1]]

kernel_name = "hymba_diffattn_gla_chunk_causal"


def lambda_init_fn(layer_idx):
    return 0.8 - 0.6 * math.exp(-0.3 * layer_idx)


def rmsnorm(x, w):
    xf = x.astype(jnp.float32)
    y = xf * lax.rsqrt(jnp.mean(xf * xf, axis=-1, keepdims=True) + NORM_EPS)
    return y * w.astype(jnp.float32)


def rope(x, pos):
    dh = x.shape[-1]
    inv_freq = ROPE_THETA ** (-jnp.arange(0, dh, 2, dtype=jnp.float32) / dh)
    ang = pos[:, None] * inv_freq[None, :]
    bshape = (1, ang.shape[0]) + (1,) * (x.ndim - 3) + (dh // 2,)
    cos = jnp.cos(ang).reshape(bshape)
    sin = jnp.sin(ang).reshape(bshape)
    x1, x2 = x[..., : dh // 2], x[..., dh // 2:]
    return jnp.concatenate([x1 * cos - x2 * sin, x2 * cos + x1 * sin], axis=-1)


def diff_attention(q, k, v, lam):
    S = q.shape[1]
    scale = DIFF_QK_DIM ** -0.5
    chunk_id = jnp.arange(S) // CHUNK
    outs = []
    for blk in range(S // Q_BLOCK):
        s0, s1 = blk * Q_BLOCK, (blk + 1) * Q_BLOCK
        qb, kb, vb = q[:, s0:s1], k[:, :s1], v[:, :s1]
        s = jnp.einsum('bqhmd,bkhmd->bmhqk', qb, kb) * scale
        mask = chunk_id[None, :s1] <= chunk_id[s0:s1, None]
        s = jnp.where(mask, s, -jnp.inf)
        p = jax.nn.softmax(s, axis=-1)
        a = p[:, 0] - lam * p[:, 1]
        outs.append(jnp.einsum('bhqk,bkhd->bqhd', a, vb))
    return jnp.concatenate(outs, axis=1)


def gla_chunk_causal(q, k, v, log_a):
    B, S, H, dk = q.shape
    dv = v.shape[-1]
    nc = S // CHUNK
    def to_chunks(t):
        return t.reshape(B, nc, CHUNK, H, t.shape[-1]).transpose(1, 0, 3, 2, 4)
    qc, kc, vc, lc = to_chunks(q), to_chunks(k), to_chunks(v), to_chunks(log_a)
    b = jnp.cumsum(lc, axis=3)
    b_tot = b[:, :, :, -1:, :]
    k_dec = kc * jnp.exp(b_tot - b)
    chunk_decay = jnp.exp(b_tot[:, :, :, 0, :])

    def step(state, inp):
        qi, ki, vi, di = inp
        state = di[..., None] * state + jnp.einsum('bhck,bhcv->bhkv', ki, vi)
        return state, jnp.einsum('bhck,bhkv->bhcv', qi, state)

    state0 = jnp.zeros((B, H, dk, dv), jnp.float32)
    _, o = lax.scan(step, state0, (qc, k_dec, vc, chunk_decay))
    return o.transpose(1, 0, 3, 2, 4).reshape(B, S, H, dv)


def setup_inputs(seed: int = 0) -> dict:
    key = jax.random.key(seed)
    ks = jax.random.split(key, 17)
    f32 = jnp.float32
    nrm = lambda k, shp, s: jax.random.normal(k, shp, f32) * s
    return {
        "x": nrm(ks[0], (BATCH, SEQ, D_MODEL), 1.0),
        "c": nrm(ks[1], (BATCH, D_MODEL), 1.0),
        "norm_w": 1.0 + nrm(ks[2], (DEPTH, D_MODEL), 0.02),
        "w_ada": nrm(ks[3], (DEPTH, D_MODEL, 3 * D_MODEL), 0.5 * D_MODEL ** -0.5),
        "b_ada": nrm(ks[4], (DEPTH, 3 * D_MODEL), 0.02),
        "w_in": nrm(ks[5], (DEPTH, D_MODEL, D_IN_PROJ), D_MODEL ** -0.5),
        "lambda_q1": nrm(ks[6], (DEPTH, DIFF_QK_DIM), 0.1),
        "lambda_k1": nrm(ks[7], (DEPTH, DIFF_QK_DIM), 0.1),
        "lambda_q2": nrm(ks[8], (DEPTH, DIFF_QK_DIM), 0.1),
        "lambda_k2": nrm(ks[9], (DEPTH, DIFF_QK_DIM), 0.1),
        "diff_norm_w": 1.0 + nrm(ks[10], (DEPTH, DIFF_HEAD_DIM), 0.02),
        "gla_gate_w2": nrm(ks[11], (DEPTH, GLA_GATE_RANK, GLA_HEADS * GLA_K_DIM), GLA_GATE_RANK ** -0.5),
        "gla_gate_b": nrm(ks[12], (DEPTH, GLA_HEADS * GLA_K_DIM), 0.1),
        "gla_norm_w": 1.0 + nrm(ks[13], (DEPTH, GLA_V_DIM), 0.02),
        "w_out": nrm(ks[14], (DEPTH, D_MIX, D_MODEL), D_MIX ** -0.5),
        "final_norm_w": 1.0 + nrm(ks[15], (D_MODEL,), 0.02),
    }


def reference(x, c, norm_w, w_ada, b_ada, w_in, lambda_q1, lambda_k1, lambda_q2, lambda_k2,
              diff_norm_w, gla_gate_w2, gla_gate_b, gla_norm_w, w_out, final_norm_w):
    B, S, _ = x.shape
    f32 = jnp.float32
    pos = jnp.arange(S, dtype=f32)
    h_res = x.astype(f32)
    c_act = jax.nn.silu(c.astype(f32))
    for l in range(DEPTH):
        lam_init = lambda_init_fn(l)
        mod = c_act @ w_ada[l].astype(f32) + b_ada[l].astype(f32)
        shift, scale, gate = jnp.split(mod, 3, axis=-1)
        hn = rmsnorm(h_res, norm_w[l]) * (1.0 + scale[:, None, :]) + shift[:, None, :]

        proj = hn @ w_in[l].astype(f32)
        dq, dk, dv, dg, gq, gk, gv, gg, glr = jnp.split(proj, IN_OFFSETS, axis=-1)

        dq = rope(dq.reshape(B, S, DIFF_HEADS, 2, DIFF_QK_DIM), pos)
        dk = rope(dk.reshape(B, S, DIFF_HEADS, 2, DIFF_QK_DIM), pos)
        dv = dv.reshape(B, S, DIFF_HEADS, DIFF_HEAD_DIM)
        lam = (jnp.exp(jnp.sum(lambda_q1[l].astype(f32) * lambda_k1[l].astype(f32)))
               - jnp.exp(jnp.sum(lambda_q2[l].astype(f32) * lambda_k2[l].astype(f32)))
               + lam_init)
        a_out = diff_attention(dq, dk, dv, lam)
        a_out = rmsnorm(a_out, diff_norm_w[l]) * (1.0 - lam_init)
        a_out = a_out.reshape(B, S, DIFF_WIDTH) * jax.nn.silu(dg)

        gq = gq.reshape(B, S, GLA_HEADS, GLA_K_DIM) * (GLA_K_DIM ** -0.5)
        gk = gk.reshape(B, S, GLA_HEADS, GLA_K_DIM)
        gv = gv.reshape(B, S, GLA_HEADS, GLA_V_DIM)
        log_a = jax.nn.log_sigmoid(glr @ gla_gate_w2[l].astype(f32) + gla_gate_b[l].astype(f32)) / GLA_GATE_TAU
        log_a = log_a.reshape(B, S, GLA_HEADS, GLA_K_DIM)
        b_out = gla_chunk_causal(gq, gk, gv, log_a)
        b_out = rmsnorm(b_out, gla_norm_w[l]).reshape(B, S, GLA_WIDTH) * jax.nn.silu(gg)

        mixed = jnp.concatenate([a_out, b_out], axis=-1) @ w_out[l].astype(f32)
        h_res = h_res + gate[:, None, :] * mixed
    return rmsnorm(h_res, final_norm_w).astype(x.dtype)
```

```cpp
#include <hip/hip_runtime.h>
#include <math.h>
#include <cstdio>

constexpr int B_ = 4, S_ = 2048, D_ = 2048, M_ = B_ * S_, NP = 7184;
constexpr int OFF_DQ = 0, OFF_DK = 1024, OFF_DV = 2048, OFF_DG = 3072, OFF_GQ = 4096, OFF_GK = 4608, OFF_GV = 5120, OFF_GG = 6144, OFF_GLR = 7168;
constexpr float EPS = 1e-6f;

__device__ __forceinline__ float silu_f(float x) { return x / (1.f + expf(-x)); }
__device__ __forceinline__ float wave_sum(float v) {
#pragma unroll
    for (int o = 1; o < 64; o <<= 1) v += __shfl_xor(v, o);
    return v;
}
__device__ __forceinline__ float wave_max(float v) {
#pragma unroll
    for (int o = 1; o < 64; o <<= 1) v = fmaxf(v, __shfl_xor(v, o));
    return v;
}

__global__ __launch_bounds__(256) void k_ada(const float* __restrict__ c, const float* __restrict__ w_ada, const float* __restrict__ b_ada, float* __restrict__ mod) {
    __shared__ float cs[4][2048];
    for (int i = threadIdx.x; i < 4 * 2048; i += 256) cs[i >> 11][i & 2047] = silu_f(c[i]);
    __syncthreads();
    const int j = blockIdx.x * 256 + threadIdx.x;
    float a0 = 0.f, a1 = 0.f, a2 = 0.f, a3 = 0.f;
    for (int k = 0; k < 2048; ++k) { const float w = w_ada[(size_t)k * 6144 + j]; a0 += cs[0][k] * w; a1 += cs[1][k] * w; a2 += cs[2][k] * w; a3 += cs[3][k] * w; }
    const float bb = b_ada[j];
    mod[0 * 6144 + j] = a0 + bb; mod[1 * 6144 + j] = a1 + bb; mod[2 * 6144 + j] = a2 + bb; mod[3 * 6144 + j] = a3 + bb;
}
__global__ void k_lam(const float* q1, const float* k1, const float* q2, const float* k2, float* lam) {
    const int l = threadIdx.x;
    const float s1 = wave_sum(q1[l] * k1[l]), s2 = wave_sum(q2[l] * k2[l]);
    if (l == 0) *lam = expf(s1) - expf(s2) + 0.2f;
}
__global__ __launch_bounds__(256) void k_rinv(const float* __restrict__ x, float* __restrict__ rinv) {
    __shared__ float red[4];
    const int m = blockIdx.x; float s = 0.f;
    for (int i = threadIdx.x; i < 2048; i += 256) { const float v = x[(size_t)m * 2048 + i]; s += v * v; }
    s = wave_sum(s); if ((threadIdx.x & 63) == 0) red[threadIdx.x >> 6] = s; __syncthreads();
    if (threadIdx.x == 0) rinv[m] = rsqrtf((red[0] + red[1] + red[2] + red[3]) * (1.f / 2048.f) + EPS);
}
template <int MODE>
__global__ __launch_bounds__(256) void k_gemm(const float* __restrict__ A, int lda, const float* __restrict__ Bm, int ldb, float* __restrict__ C, int ldc, int N, int K,
                                              const float* __restrict__ x, const float* __restrict__ rinv, const float* __restrict__ nw, const float* __restrict__ mod) {
    __shared__ float As[8][128 + 4];
    __shared__ float Bs[8][128 + 4];
    const int t = threadIdx.x, tx = t & 15, ty = t >> 4;
    const int m0 = blockIdx.y * 128, n0 = blockIdx.x * 128;
    float acc[8][8];
#pragma unroll
    for (int i = 0; i < 8; ++i)
#pragma unroll
        for (int j = 0; j < 8; ++j) acc[i][j] = 0.f;
    const int ar = t >> 1, ac = (t & 1) * 4; const int am = m0 + ar; const int ab = am >> 11;
    const int br = t >> 5, bc = (t & 31) * 4; const int bn = n0 + bc;
    const float ri = (MODE == 1) ? rinv[am] : 0.f;
    for (int k0 = 0; k0 < K; k0 += 8) {
        float4 av = *(const float4*)(A + (size_t)am * lda + k0 + ac);
        if (MODE == 1) {
            const int k = k0 + ac;
            const float4 w = *(const float4*)(nw + k), sc = *(const float4*)(mod + ab * 6144 + 2048 + k), sh = *(const float4*)(mod + ab * 6144 + k);
            av.x = av.x * ri * w.x * (1.f + sc.x) + sh.x; av.y = av.y * ri * w.y * (1.f + sc.y) + sh.y;
            av.z = av.z * ri * w.z * (1.f + sc.z) + sh.z; av.w = av.w * ri * w.w * (1.f + sc.w) + sh.w;
        }
        float4 bv = make_float4(0.f, 0.f, 0.f, 0.f);
        if (bn < N) bv = *(const float4*)(Bm + (size_t)(k0 + br) * ldb + bn);
        __syncthreads();
        As[ac + 0][ar] = av.x; As[ac + 1][ar] = av.y; As[ac + 2][ar] = av.z; As[ac + 3][ar] = av.w;
        *(float4*)&Bs[br][bc] = bv;
        __syncthreads();
#pragma unroll
        for (int kk = 0; kk < 8; ++kk) {
            const float4 a0 = *(const float4*)&As[kk][ty * 8], a1 = *(const float4*)&As[kk][ty * 8 + 4];
            const float4 b0 = *(const float4*)&Bs[kk][tx * 8], b1 = *(const float4*)&Bs[kk][tx * 8 + 4];
            const float a[8] = {a0.x, a0.y, a0.z, a0.w, a1.x, a1.y, a1.z, a1.w}, b[8] = {b0.x, b0.y, b0.z, b0.w, b1.x, b1.y, b1.z, b1.w};
#pragma unroll
            for (int i = 0; i < 8; ++i)
#pragma unroll
                for (int j = 0; j < 8; ++j) acc[i][j] += a[i] * b[j];
        }
    }
#pragma unroll
    for (int i = 0; i < 8; ++i) {
        const int m = m0 + ty * 8 + i; const int b = m >> 11;
#pragma unroll
        for (int j = 0; j < 8; ++j) {
            const int n = n0 + tx * 8 + j;
            if (n < N) {
                if (MODE == 1) C[(size_t)m * ldc + n] = acc[i][j];
                else C[(size_t)m * ldc + n] = x[(size_t)m * 2048 + n] + mod[b * 6144 + 4096 + n] * acc[i][j];
            }
        }
    }
}
__global__ __launch_bounds__(256) void k_rope(float* __restrict__ proj) {
    const size_t g = (size_t)blockIdx.x * 256 + threadIdx.x;
    const int m = (int)(g >> 10), idx = (int)(g & 1023);
    const int i = idx & 31, blk = idx >> 5;
    const int pos = m & 2047;
    const double inv = pow(10000.0, -(double)(2 * i) / 64.0);
    const double ang = (double)pos * inv;
    const float cs = (float)cos(ang), sn = (float)sin(ang);
    float* p = proj + (size_t)m * NP + blk * 64 + i;
    const float x1 = p[0], x2 = p[32];
    p[0] = x1 * cs - x2 * sn; p[32] = x2 * cs + x1 * sn;
}
constexpr int ATT_SMEM_FLOATS = 64 * 128 + 64 * 132 + 64 * 128 + 2 * 64 * 65;
__global__ __launch_bounds__(256) void k_attn(const float* __restrict__ proj, float* __restrict__ a_raw, const float* __restrict__ lamp) {
    extern __shared__ float sm[];
    float* Qs = sm; float* Ks = Qs + 64 * 128; float* Vs = Ks + 64 * 132; float* P1 = Vs + 64 * 128; float* P2 = P1 + 64 * 65;
    const int t = threadIdx.x, qr = t >> 2, qq = t & 3;
    const int blk = blockIdx.x, c = blk & 31, bh = blk >> 5, h = bh & 7, b = bh >> 3;
    const size_t rowbase = (size_t)b * 2048;
    for (int i = t; i < 64 * 32; i += 256) { const int r = i >> 5, c4 = (i & 31) * 4; *(float4*)(Qs + r * 128 + c4) = *(const float4*)(proj + (rowbase + c * 64 + r) * NP + OFF_DQ + h * 128 + c4); }
    float m1 = -INFINITY, m2 = -INFINITY, l1 = 0.f, l2 = 0.f;
    float o1[32], o2[32];
#pragma unroll
    for (int i = 0; i < 32; ++i) { o1[i] = 0.f; o2[i] = 0.f; }
    for (int kt = 0; kt <= c; ++kt) {
        __syncthreads();
        for (int i = t; i < 64 * 32; i += 256) { const int r = i >> 5, c4 = (i & 31) * 4; const float* src = proj + (rowbase + kt * 64 + r) * NP + h * 128 + c4;
            *(float4*)(Ks + r * 132 + c4) = *(const float4*)(src + OFF_DK); *(float4*)(Vs + r * 128 + c4) = *(const float4*)(src + OFF_DV); }
        __syncthreads();
        float s1[16], s2[16];
#pragma unroll
        for (int kk = 0; kk < 16; ++kk) { s1[kk] = 0.f; s2[kk] = 0.f; }
        for (int d4 = 0; d4 < 16; ++d4) {
            const float4 q1 = *(const float4*)(Qs + qr * 128 + d4 * 4), q2 = *(const float4*)(Qs + qr * 128 + 64 + d4 * 4);
#pragma unroll
            for (int kk = 0; kk < 16; ++kk) {
                const float4 k1 = *(const float4*)(Ks + (qq * 16 + kk) * 132 + d4 * 4), k2 = *(const float4*)(Ks + (qq * 16 + kk) * 132 + 64 + d4 * 4);
                s1[kk] += q1.x * k1.x + q1.y * k1.y + q1.z * k1.z + q1.w * k1.w;
                s2[kk] += q2.x * k2.x + q2.y * k2.y + q2.z * k2.z + q2.w * k2.w;
            }
        }
        float t1 = -INFINITY, t2 = -INFINITY;
#pragma unroll
        for (int kk = 0; kk < 16; ++kk) { s1[kk] *= 0.125f; s2[kk] *= 0.125f; t1 = fmaxf(t1, s1[kk]); t2 = fmaxf(t2, s2[kk]); }
        t1 = fmaxf(t1, __shfl_xor(t1, 1)); t1 = fmaxf(t1, __shfl_xor(t1, 2));
        t2 = fmaxf(t2, __shfl_xor(t2, 1)); t2 = fmaxf(t2, __shfl_xor(t2, 2));
        const float n1 = fmaxf(m1, t1), n2 = fmaxf(m2, t2);
        const float al1 = expf(m1 - n1), al2 = expf(m2 - n2);
        m1 = n1; m2 = n2; l1 *= al1; l2 *= al2;
#pragma unroll
        for (int i = 0; i < 32; ++i) { o1[i] *= al1; o2[i] *= al2; }
#pragma unroll
        for (int kk = 0; kk < 16; ++kk) {
            const float p1 = expf(s1[kk] - n1), p2 = expf(s2[kk] - n2);
            l1 += p1; l2 += p2; P1[qr * 65 + qq * 16 + kk] = p1; P2[qr * 65 + qq * 16 + kk] = p2;
        }
        __syncthreads();
        for (int key = 0; key < 64; ++key) {
            const float p1 = P1[qr * 65 + key], p2 = P2[qr * 65 + key];
#pragma unroll
            for (int g = 0; g < 8; ++g) {
                const float4 v = *(const float4*)(Vs + key * 128 + (g * 4 + qq) * 4);
                o1[g * 4 + 0] += p1 * v.x; o1[g * 4 + 1] += p1 * v.y; o1[g * 4 + 2] += p1 * v.z; o1[g * 4 + 3] += p1 * v.w;
                o2[g * 4 + 0] += p2 * v.x; o2[g * 4 + 1] += p2 * v.y; o2[g * 4 + 2] += p2 * v.z; o2[g * 4 + 3] += p2 * v.w;
            }
        }
    }
    l1 += __shfl_xor(l1, 1); l1 += __shfl_xor(l1, 2); l2 += __shfl_xor(l2, 1); l2 += __shfl_xor(l2, 2);
    const float lam = *lamp; const float i1 = 1.f / l1, i2 = lam / l2;
    float* op = a_raw + (rowbase + c * 64 + qr) * 1024 + h * 128;
#pragma unroll
    for (int g = 0; g < 8; ++g) {
        float4 v; v.x = o1[g * 4 + 0] * i1 - o2[g * 4 + 0] * i2; v.y = o1[g * 4 + 1] * i1 - o2[g * 4 + 1] * i2; v.z = o1[g * 4 + 2] * i1 - o2[g * 4 + 2] * i2; v.w = o1[g * 4 + 3] * i1 - o2[g * 4 + 3] * i2;
        *(float4*)(op + (g * 4 + qq) * 4) = v;
    }
}
__global__ __launch_bounds__(256) void k_gla_la(const float* __restrict__ proj, const float* __restrict__ w2, const float* __restrict__ bias, float* __restrict__ kdec) {
    const size_t g = (size_t)blockIdx.x * 256 + threadIdx.x; const int m = (int)(g >> 9), j = (int)(g & 511);
    float z = bias[j];
#pragma unroll
    for (int r = 0; r < 16; ++r) z += proj[(size_t)m * NP + OFF_GLR + r] * w2[r * 512 + j];
    const float ls = fminf(z, 0.f) - log1pf(expf(-fabsf(z)));
    kdec[(size_t)m * 512 + j] = ls * (1.f / 16.f);
}
__global__ __launch_bounds__(256) void k_gla_cum(const float* __restrict__ proj, float* __restrict__ kdec, float* __restrict__ decay) {
    const int g = blockIdx.x * 256 + threadIdx.x; const int j = g & 511, bc = g >> 9;
    const size_t m0 = (size_t)bc * 64; float cum = 0.f;
    for (int t = 0; t < 64; ++t) { cum += kdec[(m0 + t) * 512 + j]; kdec[(m0 + t) * 512 + j] = cum; }
    decay[(size_t)bc * 512 + j] = expf(cum);
    for (int t = 0; t < 64; ++t) kdec[(m0 + t) * 512 + j] = proj[(m0 + t) * NP + OFF_GK + j] * expf(cum - kdec[(m0 + t) * 512 + j]);
}
__global__ __launch_bounds__(256) void k_gla_scan(const float* __restrict__ proj, const float* __restrict__ kdec, const float* __restrict__ decay, float* __restrict__ b_raw) {
    const int gt = blockIdx.x * 256 + threadIdx.x;
    const int kg = gt & 3, v = (gt >> 2) & 255, bh = gt >> 10, h = bh & 3, b = bh >> 2;
    float st[32];
#pragma unroll
    for (int i = 0; i < 32; ++i) st[i] = 0.f;
    for (int c = 0; c < 32; ++c) {
        const float* dc = decay + (size_t)(b * 32 + c) * 512 + h * 128 + kg * 32;
#pragma unroll
        for (int i = 0; i < 32; ++i) st[i] *= dc[i];
        for (int t = 0; t < 64; ++t) {
            const size_t m = (size_t)b * 2048 + c * 64 + t;
            const float vv = proj[m * NP + OFF_GV + h * 256 + v]; const float* kd = kdec + m * 512 + h * 128 + kg * 32;
#pragma unroll
            for (int i = 0; i < 32; ++i) st[i] += kd[i] * vv;
        }
        for (int t = 0; t < 64; ++t) {
            const size_t m = (size_t)b * 2048 + c * 64 + t;
            const float* q = proj + m * NP + OFF_GQ + h * 128 + kg * 32; float o = 0.f;
#pragma unroll
            for (int i = 0; i < 32; ++i) o += q[i] * st[i];
            o += __shfl_xor(o, 1); o += __shfl_xor(o, 2);
            if (kg == 0) b_raw[m * 1024 + h * 256 + v] = o * 0.08838834764831845f;
        }
    }
}
__global__ __launch_bounds__(256) void k_mix(float* __restrict__ proj, const float* __restrict__ a_raw, const float* __restrict__ b_raw, const float* __restrict__ dnw, const float* __restrict__ gnw) {
    __shared__ float raw[2048]; __shared__ float hs[12];
    const int m = blockIdx.x, t = threadIdx.x;
    for (int i = t; i < 2048; i += 256) raw[i] = (i < 1024) ? a_raw[(size_t)m * 1024 + i] : b_raw[(size_t)m * 1024 + i - 1024];
    __syncthreads();
    if (t < 8) { float s = 0.f; for (int i = 0; i < 128; ++i) { const float v = raw[t * 128 + i]; s += v * v; } hs[t] = rsqrtf(s * (1.f / 128.f) + EPS); }
    else if (t < 12) { float s = 0.f; for (int i = 0; i < 256; ++i) { const float v = raw[1024 + (t - 8) * 256 + i]; s += v * v; } hs[t] = rsqrtf(s * (1.f / 256.f) + EPS); }
    __syncthreads();
    for (int i = t; i < 2048; i += 256) {
        float val;
        if (i < 1024) val = raw[i] * hs[i >> 7] * dnw[i & 127] * 0.8f * silu_f(proj[(size_t)m * NP + OFF_DG + i]);
        else { const int j = i - 1024; val = raw[i] * hs[8 + (j >> 8)] * gnw[j & 255] * silu_f(proj[(size_t)m * NP + OFF_GG + j]); }
        proj[(size_t)m * NP + i] = val;
    }
}
__global__ __launch_bounds__(256) void k_final(float* __restrict__ out, const float* __restrict__ fw) {
    __shared__ float red[4];
    const int m = blockIdx.x; float s = 0.f; float v[8];
#pragma unroll
    for (int i = 0; i < 8; ++i) { v[i] = out[(size_t)m * 2048 + i * 256 + threadIdx.x]; s += v[i] * v[i]; }
    s = wave_sum(s); if ((threadIdx.x & 63) == 0) red[threadIdx.x >> 6] = s; __syncthreads();
    const float r = rsqrtf((red[0] + red[1] + red[2] + red[3]) * (1.f / 2048.f) + EPS);
#pragma unroll
    for (int i = 0; i < 8; ++i) out[(size_t)m * 2048 + i * 256 + threadIdx.x] = v[i] * r * fw[i * 256 + threadIdx.x];
}

extern "C" void kernel_launch(void* const* d_in, const int* in_sizes, int n_in, void* d_out, int out_size, void* d_ws, size_t ws_size, hipStream_t stream) {
    const float* x = (const float*)d_in[0]; const float* c = (const float*)d_in[1]; const float* norm_w = (const float*)d_in[2];
    const float* w_ada = (const float*)d_in[3]; const float* b_ada = (const float*)d_in[4]; const float* w_in = (const float*)d_in[5];
    const float* lq1 = (const float*)d_in[6]; const float* lk1 = (const float*)d_in[7]; const float* lq2 = (const float*)d_in[8]; const float* lk2 = (const float*)d_in[9];
    const float* dnw = (const float*)d_in[10]; const float* w2 = (const float*)d_in[11]; const float* gb = (const float*)d_in[12]; const float* gnw = (const float*)d_in[13];
    const float* w_out = (const float*)d_in[14]; const float* fnw = (const float*)d_in[15];
    float* out = (float*)d_out; float* ws = (float*)d_ws;
    float* mod = ws;
    float* lam = ws + 32768;
    float* rinv = ws + 32768 + 64;
    float* decay = ws + 65536;
    float* proj = ws + 262144;
    float* kdec = proj + (size_t)M_ * NP;
    float* a_raw = out; float* b_raw = out + (size_t)M_ * 1024;
    static bool attr_done = false;
    if (!attr_done) { (void)hipFuncSetAttribute((const void*)k_attn, hipFuncAttributeMaxDynamicSharedMemorySize, ATT_SMEM_FLOATS * 4); attr_done = true; }

    k_ada<<<6144 / 256, 256, 0, stream>>>(c, w_ada, b_ada, mod);
    k_lam<<<1, 64, 0, stream>>>(lq1, lk1, lq2, lk2, lam);
    k_rinv<<<M_, 256, 0, stream>>>(x, rinv);
    k_gemm<1><<<dim3((NP + 127) / 128, M_ / 128), 256, 0, stream>>>(x, 2048, w_in, NP, proj, NP, NP, 2048, x, rinv, norm_w, mod);
    k_rope<<<M_ * 1024 / 256, 256, 0, stream>>>(proj);
    k_attn<<<4 * 8 * 32, 256, ATT_SMEM_FLOATS * 4, stream>>>(proj, a_raw, lam);
    k_gla_la<<<M_ * 512 / 256, 256, 0, stream>>>(proj, w2, gb, kdec);
    k_gla_cum<<<4 * 32 * 512 / 256, 256, 0, stream>>>(proj, kdec, decay);
    k_gla_scan<<<16384 / 256, 256, 0, stream>>>(proj, kdec, decay, b_raw);
    k_mix<<<M_, 256, 0, stream>>>(proj, a_raw, b_raw, dnw, gnw);
    k_gemm<2><<<dim3(2048 / 128, M_ / 128), 256, 0, stream>>>(proj, NP, w_out, 2048, out, 2048, 2048, 2048, x, rinv, norm_w, mod);
    k_final<<<M_, 256, 0, stream>>>(out, fnw);
}
```

```cpp
#include <hip/hip_runtime.h>
#include <hip/hip_bf16.h>
#include <cstdio>
#include <cstdint>
#include <cmath>
constexpr int PITCH = 7424;
namespace pg8 {
#define PG8_LAS __attribute__((address_space(3)))
typedef unsigned short bf16_t;
typedef short bf16x8 __attribute__((ext_vector_type(8)));
typedef float f32x4 __attribute__((ext_vector_type(4)));
typedef unsigned u32x4 __attribute__((ext_vector_type(4)));
constexpr int BM = 256, BK = 64, HALF = 128, HTB = HALF * BK * 2  , STAGE_BYTES = 8 * HTB, NXCD = 8, WGM = 8;

__host__ __device__ __forceinline__ int lds_byte(int r, int c) { const int st = (r >> 4) * 2 + (c >> 5), rr = r & 15, cc = c & 31, ob = rr * 64 + cc * 2; return st * 1024 + (ob ^ (((ob >> 9) & 1) << 5)); }
__host__ __device__ __forceinline__ void stage_rc(int b, int& R, int& C) { const int st = b / 1024, sb = b % 1024, swz = sb ^ (((sb >> 9) & 1) << 5); R = (st >> 1) * 16 + swz / 64; C = (st & 1) * 32 + (swz % 64) / 2; }
__host__ __device__ __forceinline__ int perm32(int rho) { const int n = rho >> 4, i = rho & 15; return 8 * (i >> 2) + 4 * n + (i & 3); }

struct Unit { int pm, pn; };
struct Gemm { const bf16_t* A; const bf16_t* Bt; int M, N, K; };

struct StaticOrder {
    int nM, nN, nwg, G, c;
    __host__ __device__ void init(int M, int N, int G_, int c_) { nM = M / BM; nN = N / BM; nwg = nM * nN; G = G_; c = c_; }
    __host__ __device__ bool next(int i, Unit& u) const {
        const long L = (long)i * G + c; if (L >= nwg) return false;
        int wgid = (int)L; { const int q = nwg / NXCD, r = nwg % NXCD, xcd = wgid % NXCD, off = wgid / NXCD; wgid = (xcd < r ? xcd * (q + 1) : r * (q + 1) + (xcd - r) * q) + off; }
        const int nig = WGM * nN, gid = wgid / nig, fm = gid * WGM, gsz = (nM - fm) < WGM ? (nM - fm) : WGM;
        u.pm = fm + ((wgid % nig) % gsz); u.pn = (wgid % nig) / gsz; return true;
    }
    __device__ __forceinline__ void a_ready(const Unit&) const {}
    __device__ __forceinline__ void done(const Unit&) const {}
};
__device__ __forceinline__ unsigned cvt_pk_bf16(float lo, float hi) { unsigned r; asm volatile("v_cvt_pk_bf16_f32 %0, %1, %2" : "=v"(r) : "v"(lo), "v"(hi)); return r; }
typedef float f32x2 __attribute__((ext_vector_type(2)));
typedef unsigned u32x2 __attribute__((ext_vector_type(2)));
__device__ __forceinline__ float fast_silu(float v) { return v * __builtin_amdgcn_rcpf(1.0f + __builtin_amdgcn_exp2f(-1.4426950408889634f * v)); }
struct EpiProj {
    static constexpr int PERM = 2; static constexpr bool AFTER_DRAIN = false;
    bf16_t* P; const float* rope;
    template <int MODE> __device__ __forceinline__ void run(const f32x4 (&acc)[2][2][4][2], int row0, int cb, int dsub) const {
#pragma unroll
        for (int ai = 0; ai < 2; ++ai)
#pragma unroll
            for (int m = 0; m < 4; ++m) {
                const int row = row0 + ai * HALF + m * 16;
                bf16_t* rowp = P + (size_t)row * PITCH + cb;
                f32x4 c4 = {0.f, 0.f, 0.f, 0.f}, s4 = {0.f, 0.f, 0.f, 0.f};
                if (MODE <= 1) { const f32x4* rp = (const f32x4*)(rope + ((size_t)(row & 2047) * 32 + dsub) * 2); const f32x4 t0 = rp[0], t1 = rp[1];
                    c4 = (f32x4){t0[0], t0[2], t1[0], t1[2]}; s4 = (f32x4){t0[1], t0[3], t1[1], t1[3]}; }
#pragma unroll
                for (int bj = 0; bj < 2; ++bj) {
                    f32x4 x1 = acc[ai][bj][m][0], x2 = acc[ai][bj][m][1];
                    if (MODE <= 1) { f32x4 o1 = x1 * c4 - x2 * s4, o2 = x2 * c4 + x1 * s4; if (MODE == 0) { o1 = o1 * 0.18033688011112042f; o2 = o2 * 0.18033688011112042f; } x1 = o1; x2 = o2; }
                    else if (MODE == 2) {
#pragma unroll
                        for (int i = 0; i < 4; ++i) { x1[i] = fast_silu(x1[i]); x2[i] = fast_silu(x2[i]); } }
                    else if (MODE == 3) { x1 = x1 * 0.08838834764831845f; x2 = x2 * 0.08838834764831845f; }
                    u32x2 w1, w2; w1.x = cvt_pk_bf16(x1[0], x1[1]); w1.y = cvt_pk_bf16(x1[2], x1[3]); w2.x = cvt_pk_bf16(x2[0], x2[1]); w2.y = cvt_pk_bf16(x2[2], x2[3]);
                    *(u32x2*)(rowp + bj * HALF) = w1; *(u32x2*)(rowp + bj * HALF + 32) = w2;
                }
            }
    }
    __device__ __forceinline__ void operator()(const f32x4 (&acc)[2][2][4][2], const Unit& u, int wr, int wc, int fr, int fq) const {
        const int pn = u.pn, row0 = u.pm * BM + wr * 64 + fr, dsub = 16 * (wc & 1) + 4 * fq;
        const int cb = pn * BM + 64 * (wc >> 1) + dsub;
        if (pn < 4) run<0>(acc, row0, cb, dsub);
        else if (pn < 8) run<1>(acc, row0, cb, dsub);
        else if ((pn >= 12 && pn < 16) || (pn >= 24 && pn < 28)) run<2>(acc, row0, cb, dsub);
        else if (pn == 16 || pn == 17) run<3>(acc, row0, pn * BM + 64 * (wc >> 1) + 16 * (wc & 1) + 4 * (((fq & 1) << 1) | (fq >> 1)), dsub);
        else run<4>(acc, row0, cb, dsub);
    }
};
struct EpiOut {
    static constexpr int PERM = 0; static constexpr bool AFTER_DRAIN = false;
    const float* x; float* out; const float* mod; float* rowss;
    __device__ __forceinline__ void operator()(const f32x4 (&acc)[2][2][4][2], const Unit& u, int wr, int wc, int fr, int fq) const {
        const int row0 = u.pm * BM + wr * 64 + fr, col0 = u.pn * BM + wc * 32 + 4 * fq, b = (u.pm * BM) >> 11;
        f32x4 g[2][2];
#pragma unroll
        for (int bj = 0; bj < 2; ++bj)
#pragma unroll
            for (int n = 0; n < 2; ++n) g[bj][n] = *(const f32x4*)(mod + b * 6144 + 4096 + col0 + bj * HALF + n * 16);
#pragma unroll
        for (int ai = 0; ai < 2; ++ai)
#pragma unroll
            for (int m = 0; m < 4; ++m) {
                const int row = row0 + ai * HALF + m * 16; const size_t rp = (size_t)row * 2048 + col0; float ss = 0.f;
#pragma unroll
                for (int bj = 0; bj < 2; ++bj)
#pragma unroll
                    for (int n = 0; n < 2; ++n) { const f32x4 xv = *(const f32x4*)(x + rp + bj * HALF + n * 16); const f32x4 hv = xv + g[bj][n] * acc[ai][bj][m][n];
                        *(f32x4*)(out + rp + bj * HALF + n * 16) = hv; ss += (hv[0] * hv[0] + hv[1] * hv[1]) + (hv[2] * hv[2] + hv[3] * hv[3]); }
                ss += __shfl_xor(ss, 16); ss += __shfl_xor(ss, 32);
                if (fq == 0) atomicAdd(rowss + row, ss);
            }
    }
};
template <class Epi, class Sched, bool ALIGN_EPI = false, bool SP2 = false>
__device__ __forceinline__ void gemm_phase(PG8_LAS unsigned char* lds, const Gemm g, const Sched& S, const Epi& E) {
    const int tid = threadIdx.x, wid = __builtin_amdgcn_readfirstlane(tid >> 6), lane = tid & 63, wr = wid >> 2, wc = wid & 3, fr = lane & 15, fq = lane >> 4;
    const int K = g.K, nt = K / BK;
    unsigned voffA[2], voffB[2];
#pragma unroll
    for (int i = 0; i < 2; ++i) { int R, C; stage_rc(tid * 16 + i * 8192, R, C); const int Rb = Epi::PERM == 1 ? ((R & ~31) + perm32(R & 31)) : Epi::PERM == 2 ? ((R & ~48) | ((R & 16) << 1) | ((R & 32) >> 1)) : R;
        voffA[i] = (unsigned)(R * K + C) * 2u; voffB[i] = (unsigned)(Rb * K + C) * 2u; }
    const size_t kstep = (size_t)(BK * 2);
    const size_t hstep = (size_t)HALF * K * 2;
    const size_t tstep = 2 * hstep;
    const unsigned ldsw = (unsigned)wid * 1024u;
    const int aoff = lds_byte(wr * 64 + fr, fq * 8), boff = lds_byte(wc * 32 + fr, fq * 8);
#define PG8_SA(b, h) (((b) * 2 + (h)) * HTB)
#define PG8_SB(b, h) ((4 + (b) * 2 + (h)) * HTB)
#define PG8_STAGE(bufoff, gbase, voff) do { _Pragma("unroll") for (int _i = 0; _i < 2; ++_i) \
        __builtin_amdgcn_global_load_lds((const unsigned*)((const char*)(gbase) + (voff)[_i]), (PG8_LAS unsigned*)(lds + (bufoff) + ldsw + _i * 8192), 16, 0, 0); } while (0)
#define PG8_LDA(dst, b, h) do { _Pragma("unroll") for (int m = 0; m < 4; ++m) _Pragma("unroll") for (int k = 0; k < 2; ++k) dst[m][k] = *(const PG8_LAS bf16x8*)(lds + PG8_SA(b, h) + aoff + m * 2048 + k * 1024); } while (0)
#define PG8_LDB(dst, b, h) do { _Pragma("unroll") for (int n = 0; n < 2; ++n) _Pragma("unroll") for (int k = 0; k < 2; ++k) dst[n][k] = *(const PG8_LAS bf16x8*)(lds + PG8_SB(b, h) + boff + n * 2048 + k * 1024); } while (0)
#define PG8_MMA(ai, bj, At, Bt) do { __builtin_amdgcn_s_setprio(1); _Pragma("unroll") for (int m = 0; m < 4; ++m) _Pragma("unroll") for (int n = 0; n < 2; ++n) _Pragma("unroll") for (int k = 0; k < 2; ++k) \
        acc[ai][bj][m][n] = __builtin_amdgcn_mfma_f32_16x16x32_bf16(Bt[n][k], At[m][k], acc[ai][bj][m][n], 0, 0, 0); __builtin_amdgcn_s_setprio(0); } while (0)
#define PG8_WAIT_V(n) asm volatile("s_waitcnt vmcnt(" #n ")" ::: "memory")
#define PG8_WAIT_L(n) asm volatile("s_waitcnt lgkmcnt(" #n ")" ::: "memory")
#define PG8_BAR __builtin_amdgcn_s_barrier()
#define PG8_SCHED __builtin_amdgcn_sched_barrier(0)
    Unit cur, nxt; int ui = 0;
    if (!S.next(0, cur)) return;
    f32x4 acc[2][2][4][2];
#pragma unroll
    for (int a = 0; a < 2; ++a)
#pragma unroll
        for (int b = 0; b < 2; ++b)
#pragma unroll
            for (int m = 0; m < 4; ++m)
#pragma unroll
                for (int n = 0; n < 2; ++n) acc[a][b][m][n] = (f32x4){0.f, 0.f, 0.f, 0.f};
    bf16x8 At[4][2], B0[2][2], B1[2][2];
    const char* cA = (const char*)g.A + (size_t)cur.pm * tstep; const char* cB = (const char*)g.Bt + (size_t)cur.pn * tstep;
    S.a_ready(cur);
    if constexpr (SP2) {
        PG8_STAGE(PG8_SB(0, 0), cB, voffB); PG8_STAGE(PG8_SB(0, 1), cB + hstep, voffB); PG8_STAGE(PG8_SA(0, 0), cA, voffA); PG8_STAGE(PG8_SA(0, 1), cA + hstep, voffA);
        if (wr == 1) PG8_BAR;
        PG8_WAIT_V(2); PG8_BAR;
        PG8_STAGE(PG8_SB(1, 0), cB + kstep, voffB); PG8_STAGE(PG8_SA(1, 0), cA + kstep, voffA); PG8_STAGE(PG8_SB(1, 1), cB + hstep + kstep, voffB);
        PG8_WAIT_V(6); PG8_BAR;
    } else {
        PG8_STAGE(PG8_SB(0, 0), cB, voffB); PG8_STAGE(PG8_SA(0, 0), cA, voffA); PG8_STAGE(PG8_SB(0, 1), cB + hstep, voffB); PG8_STAGE(PG8_SA(0, 1), cA + hstep, voffA);
        if (wr == 1) PG8_BAR;
        PG8_WAIT_V(4); PG8_BAR;
        PG8_STAGE(PG8_SB(1, 0), cB + kstep, voffB); PG8_STAGE(PG8_SA(1, 0), cA + kstep, voffA); PG8_STAGE(PG8_SB(1, 1), cB + hstep + kstep, voffB);
        PG8_WAIT_V(6); PG8_BAR;
    }
    for (;;) {
        const bool has_next = S.next(ui + 1, nxt);
        const char* nA = has_next ? (const char*)g.A + (size_t)nxt.pm * tstep : cA; const char* nB = has_next ? (const char*)g.Bt + (size_t)nxt.pn * tstep : cB;
        for (int t = 0; t < nt; t += 2) {
            const bool last = (t == nt - 2);
            const char* a1 = cA + (size_t)(t + 1) * kstep;
            const char* a2 = last ? nA : cA + (size_t)(t + 2) * kstep; const char* b2 = last ? nB : cB + (size_t)(t + 2) * kstep;
            const char* a3 = a2 + kstep; const char* b3 = b2 + kstep;
            if (last && has_next) S.a_ready(nxt);
            if constexpr (SP2) {
            PG8_LDB(B0, 0, 0); PG8_LDB(B1, 0, 1); PG8_SCHED; PG8_LDA(At, 0, 0); PG8_STAGE(PG8_SA(1, 1), a1 + hstep, voffA);
            PG8_WAIT_V(8); PG8_WAIT_L(0); PG8_BAR; PG8_MMA(0, 0, At, B0); PG8_MMA(0, 1, At, B1); PG8_BAR; PG8_SCHED;
            PG8_LDA(At, 0, 1); PG8_STAGE(PG8_SB(0, 0), b2, voffB); PG8_STAGE(PG8_SB(0, 1), b2 + hstep, voffB); PG8_STAGE(PG8_SA(0, 0), a2, voffA);
            PG8_WAIT_V(8); PG8_WAIT_L(0); PG8_BAR; PG8_MMA(1, 0, At, B0); PG8_MMA(1, 1, At, B1); PG8_BAR; PG8_SCHED;
            PG8_LDB(B0, 1, 0); PG8_LDB(B1, 1, 1); PG8_SCHED; PG8_LDA(At, 1, 0); PG8_STAGE(PG8_SA(0, 1), a2 + hstep, voffA);
            PG8_WAIT_V(8); PG8_WAIT_L(0); PG8_BAR; PG8_MMA(0, 0, At, B0); PG8_MMA(0, 1, At, B1); PG8_BAR; PG8_SCHED;
            PG8_LDA(At, 1, 1); PG8_STAGE(PG8_SB(1, 0), b3, voffB); PG8_STAGE(PG8_SB(1, 1), b3 + hstep, voffB); PG8_STAGE(PG8_SA(1, 0), a3, voffA);
            PG8_WAIT_V(8); PG8_WAIT_L(0); PG8_BAR; PG8_MMA(1, 0, At, B0); PG8_MMA(1, 1, At, B1); PG8_BAR; PG8_SCHED;
            } else {
            PG8_LDB(B0, 0, 0); PG8_SCHED; PG8_LDA(At, 0, 0); PG8_STAGE(PG8_SA(1, 1), a1 + hstep, voffA);
            PG8_WAIT_L(8); PG8_BAR; PG8_WAIT_L(0); PG8_MMA(0, 0, At, B0); PG8_BAR; PG8_SCHED;
            PG8_LDB(B1, 0, 1); PG8_STAGE(PG8_SB(0, 0), b2, voffB);
            PG8_BAR; PG8_WAIT_L(0); PG8_MMA(0, 1, At, B1); PG8_BAR;
            PG8_LDA(At, 0, 1); PG8_STAGE(PG8_SA(0, 0), a2, voffA);
            PG8_BAR; PG8_WAIT_L(0); PG8_MMA(1, 0, At, B0); PG8_BAR; PG8_SCHED;
            PG8_STAGE(PG8_SB(0, 1), b2 + hstep, voffB);
            PG8_WAIT_V(6); PG8_BAR; PG8_MMA(1, 1, At, B1); PG8_BAR;
            PG8_LDB(B0, 1, 0); PG8_SCHED; PG8_LDA(At, 1, 0); PG8_STAGE(PG8_SA(0, 1), a2 + hstep, voffA);
            PG8_WAIT_L(8); PG8_BAR; PG8_WAIT_L(0); PG8_MMA(0, 0, At, B0); PG8_BAR; PG8_SCHED;
            PG8_LDB(B1, 1, 1); PG8_STAGE(PG8_SB(1, 0), b3, voffB);
            PG8_BAR; PG8_WAIT_L(0); PG8_MMA(0, 1, At, B1); PG8_BAR;
            PG8_LDA(At, 1, 1); PG8_STAGE(PG8_SA(1, 0), a3, voffA);
            PG8_BAR; PG8_WAIT_L(0); PG8_MMA(1, 0, At, B0); PG8_BAR; PG8_SCHED;
            PG8_STAGE(PG8_SB(1, 1), b3 + hstep, voffB);
            PG8_WAIT_V(6); PG8_BAR; PG8_MMA(1, 1, At, B1); PG8_BAR;
            }
        }
        if constexpr (ALIGN_EPI) { if (wr == 0) PG8_BAR; }
        if constexpr (!Epi::AFTER_DRAIN) { E(acc, cur, wr, wc, fr, fq); S.done(cur); }
        if (!has_next) break;
#pragma unroll
        for (int a = 0; a < 2; ++a)
#pragma unroll
            for (int b = 0; b < 2; ++b)
#pragma unroll
                for (int m = 0; m < 4; ++m)
#pragma unroll
                    for (int n = 0; n < 2; ++n) acc[a][b][m][n] = (f32x4){0.f, 0.f, 0.f, 0.f};
        cur = nxt; cA = nA; cB = nB; ++ui;
        if constexpr (ALIGN_EPI) { if (wr == 1) PG8_BAR; }
    }
    PG8_WAIT_V(0);
    if constexpr (!ALIGN_EPI) { if (wr == 0) PG8_BAR; }
    PG8_BAR;
    if constexpr (Epi::AFTER_DRAIN) { E.fused(acc, cur, wr, wc, fr, fq, lds, wid, lane); S.done(cur); }
#undef PG8_SA
#undef PG8_SB
#undef PG8_STAGE
#undef PG8_LDA
#undef PG8_LDB
#undef PG8_MMA
#undef PG8_WAIT_V
#undef PG8_WAIT_L
#undef PG8_BAR
#undef PG8_SCHED
}
}
namespace att {
#define ALAS __attribute__((address_space(3)))
using bf16x8 = __attribute__((ext_vector_type(8))) short;
using s16x4 = __attribute__((ext_vector_type(4))) short;
using f32x16 = __attribute__((ext_vector_type(16))) float;
using f32x4a = __attribute__((ext_vector_type(4))) float;
using u32x4 = __attribute__((ext_vector_type(4))) unsigned;
typedef short v4i16_t __attribute__((ext_vector_type(4)));
typedef unsigned short bf16raw;
constexpr int LDS_K = 0, LDS_V = 32768, TILEB = 16384, LDS_X = 0, XSTR = 132, LDS_WS = 69632, LDS_BYTES = LDS_WS + 8 * 256;
__device__ __forceinline__ int crow(int r, int hi) { return (r & 3) + 8 * (r >> 2) + 4 * hi; }
__device__ __forceinline__ void glds16(const void* gsrc, unsigned lds_dst) { unsigned keep;
    asm volatile("s_mov_b32 %0, m0\n\ts_mov_b32 m0, %2\n\ts_nop 0\n\tglobal_load_lds_dwordx4 %1, off\n\ts_mov_b32 m0, %0" : "=&s"(keep) : "v"(gsrc), "s"(lds_dst) : "memory"); }
typedef float f32x2_t __attribute__((ext_vector_type(2))); typedef __bf16 bf16x2_t __attribute__((ext_vector_type(2)));
__device__ __forceinline__ unsigned cvtpk(float lo, float hi) { f32x2_t v = {lo, hi}; bf16x2_t b = __builtin_convertvector(v, bf16x2_t); return __builtin_bit_cast(unsigned, b); }
__device__ __forceinline__ float bf2f(unsigned short u) { return __uint_as_float((unsigned)u << 16); }
__device__ __forceinline__ s16x4 vtr(const ALAS char* p) { return __builtin_bit_cast(s16x4, __builtin_amdgcn_ds_read_tr16_b64_v4i16((ALAS v4i16_t*)p)); }
#define ATT_WAITBAR() asm volatile("s_waitcnt vmcnt(0) lgkmcnt(0)\n\ts_barrier" ::: "memory")
#define ATT_LBAR() asm volatile("s_waitcnt lgkmcnt(0)\n\ts_barrier" ::: "memory")
__device__ __forceinline__ float halfswap_max(float m) { auto rr = __builtin_amdgcn_permlane32_swap(__float_as_uint(m), __float_as_uint(m), false, false); return fmaxf(__uint_as_float(rr[0]), __uint_as_float(rr[1])); }
__device__ __forceinline__ float halfswap_add(float m) { auto rr = __builtin_amdgcn_permlane32_swap(__float_as_uint(m), __float_as_uint(m), false, false); return __uint_as_float(rr[0]) + __uint_as_float(rr[1]); }

__device__ __forceinline__ void attn_unit(int b, int h, int qb2, const bf16raw* proj, bf16raw* mix, const float* dnw, float lam, ALAS char* sh3) {
    const int tid = threadIdx.x, lane = tid & 63, r32 = lane & 31, hi = lane >> 5; const int wid = __builtin_amdgcn_readfirstlane(tid >> 6);
    const int rg = wid >> 1, comp = wid & 1;
    const long rowbase = (long)b * 2048; const int q0 = qb2 * 128;
    const int NT = 2 * qb2 + 2, myNT = 2 * qb2 + 1 + (rg >> 1);
    const unsigned lds0 = (unsigned)(uintptr_t)sh3;
    ALAS float* wsf = (ALAS float*)(sh3 + LDS_WS) + wid * 64;
    const bf16raw* Qw = proj + (rowbase + q0 + rg * 32 + r32) * PITCH + h * 128 + comp * 64 + hi * 8;
    bf16x8 qr[4];
#pragma unroll
    for (int d0 = 0; d0 < 4; ++d0) qr[d0] = *(const bf16x8*)(Qw + d0 * 16);
    const bf16raw* ksrc = proj + (rowbase + lane) * PITCH + 1024 + h * 128 + (2 * wid) * 8;
    const bf16raw* vsrc = proj + (rowbase + 32 * (wid & 1) + (lane >> 2)) * PITCH + 2048 + h * 128 + (wid >> 1) * 32 + (lane & 3) * 8;
    const unsigned kdst = lds0 + LDS_K + (2 * wid) * 1024, vdst = lds0 + LDS_V + (2 * wid) * 1024;
#define ATT_DMA(t, buf) do { const bf16raw* ks_ = ksrc + (long)(t) * 64 * PITCH; const bf16raw* vs_ = vsrc + (long)(t) * 64 * PITCH; const unsigned bo_ = (unsigned)(buf) * TILEB; \
        glds16(ks_, (unsigned)__builtin_amdgcn_readfirstlane(kdst + bo_)); glds16(ks_ + 8, (unsigned)__builtin_amdgcn_readfirstlane(kdst + bo_ + 1024)); \
        glds16(vs_, (unsigned)__builtin_amdgcn_readfirstlane(vdst + bo_)); glds16(vs_ + 16 * PITCH, (unsigned)__builtin_amdgcn_readfirstlane(vdst + bo_ + 1024)); } while (0)
    float mrun = 0.f, l = 0.f;
    f32x16 o[4];
#pragma unroll
    for (int d = 0; d < 4; ++d) o[d] = f32x16{};
    const ALAS char* kp0 = sh3 + LDS_K + (comp * 8 + hi) * 1024 + r32 * 16;
    const ALAS char* vp0 = sh3 + LDS_V + ((lane >> 4) & 1) * 32 + (lane & 3) * 8 + (4 * hi + ((lane & 15) >> 2)) * 64;
    ATT_DMA(0, 0);
    for (int t = 0; t < NT; ++t) {
        const int buf = t & 1;
        ATT_WAITBAR();
        if (t + 1 < NT) ATT_DMA(t + 1, buf ^ 1);
        if (t < myNT) {
            const ALAS char* kp = kp0 + buf * TILEB; const ALAS char* vp = vp0 + buf * TILEB;
            f32x16 p0 = f32x16{}, p1 = f32x16{};
#pragma unroll
            for (int d0 = 0; d0 < 4; ++d0) {
                const bf16x8 a0 = *(const ALAS bf16x8*)(kp + d0 * 2048), a1 = *(const ALAS bf16x8*)(kp + d0 * 2048 + 512);
                p0 = __builtin_amdgcn_mfma_f32_32x32x16_bf16(a0, qr[d0], p0, 0, 0, 0);
                p1 = __builtin_amdgcn_mfma_f32_32x32x16_bf16(a1, qr[d0], p1, 0, 0, 0);
            }
            float rm = fmaxf(p0[0], p1[0]);
#pragma unroll
            for (int r = 1; r < 16; ++r) rm = fmaxf(rm, fmaxf(p0[r], p1[r]));
            rm = halfswap_max(rm);
            if (t == 0) mrun = rm;
            else if (__any(rm > mrun + 8.0f)) {
                const float mn = fmaxf(mrun, rm), f = __builtin_amdgcn_exp2f(mrun - mn); mrun = mn; l *= f;
                if (hi == 0) wsf[r32] = f;
                asm volatile("s_waitcnt lgkmcnt(0)" ::: "memory");
#pragma unroll
                for (int r = 0; r < 16; ++r) { const float fr_ = wsf[crow(r, hi)];
#pragma unroll
                    for (int d = 0; d < 4; ++d) o[d][r] *= fr_; }
            }
            float sacc = 0.f;
#pragma unroll
            for (int r = 0; r < 16; ++r) { p0[r] = __builtin_amdgcn_exp2f(p0[r] - mrun); p1[r] = __builtin_amdgcn_exp2f(p1[r] - mrun); sacc += p0[r] + p1[r]; }
            l += sacc;
            u32x4 pw[4];
#pragma unroll
            for (int i = 0; i < 4; ++i) { pw[0][i] = cvtpk(p0[2 * i], p0[2 * i + 1]); pw[1][i] = cvtpk(p0[8 + 2 * i], p0[8 + 2 * i + 1]); pw[2][i] = cvtpk(p1[2 * i], p1[2 * i + 1]); pw[3][i] = cvtpk(p1[8 + 2 * i], p1[8 + 2 * i + 1]); }
#pragma unroll
            for (int d0 = 0; d0 < 4; ++d0)
#pragma unroll
                for (int ks = 0; ks < 4; ++ks) {
                    const s16x4 lo = vtr(vp + (d0 * 4 + ks) * 1024), hh = vtr(vp + (d0 * 4 + ks) * 1024 + 512);
                    const bf16x8 vf = (bf16x8){lo[0], lo[1], lo[2], lo[3], hh[0], hh[1], hh[2], hh[3]};
                    o[d0] = __builtin_amdgcn_mfma_f32_32x32x16_bf16(__builtin_bit_cast(bf16x8, pw[ks]), vf, o[d0], 0, 0, 0);
                }
        }
    }
    l = halfswap_add(l);
    if (hi == 0) wsf[r32] = (comp ? lam : 1.0f) / l;
    asm volatile("s_waitcnt lgkmcnt(0)" ::: "memory");
    float rli[16];
#pragma unroll
    for (int r = 0; r < 16; ++r) rli[r] = wsf[crow(r, hi)];
    ATT_WAITBAR();
    ALAS float* X = (ALAS float*)(sh3 + LDS_X) + rg * 32 * XSTR;
    if (comp == 1) {
#pragma unroll
        for (int d = 0; d < 4; ++d)
#pragma unroll
            for (int r = 0; r < 16; ++r) X[crow(r, hi) * XSTR + d * 32 + r32] = o[d][r] * rli[r];
    }
    ATT_LBAR();
    if (comp == 0) {
#pragma unroll
        for (int d = 0; d < 4; ++d)
#pragma unroll
            for (int r = 0; r < 16; ++r) { const int ix = crow(r, hi) * XSTR + d * 32 + r32; X[ix] = o[d][r] * rli[r] - X[ix]; }
    }
    ATT_LBAR();
    {
        const int row = 16 * comp + (lane >> 2), seg = lane & 3;
        const ALAS f32x4a* xr = (const ALAS f32x4a*)(X + row * XSTR + seg * 32);
        f32x4a v[8]; float ss = 0.f;
#pragma unroll
        for (int i = 0; i < 8; ++i) { v[i] = xr[i]; ss += (v[i][0] * v[i][0] + v[i][1] * v[i][1]) + (v[i][2] * v[i][2] + v[i][3] * v[i][3]); }
        ss += __shfl_xor(ss, 1); ss += __shfl_xor(ss, 2);
        const float rinv = 0.8f / sqrtf(ss * (1.0f / 128.0f) + 1e-6f);
        const long m = rowbase + q0 + rg * 32 + row;
        const bf16raw* gp = proj + m * PITCH + 3072 + h * 128 + seg * 32;
        bf16raw* op = mix + m * 2048 + h * 128 + seg * 32;
        const float* wp = dnw + seg * 32;
#pragma unroll
        for (int i = 0; i < 4; ++i) {
            const u32x4 gq = *(const u32x4*)(gp + i * 8); const f32x4a w0 = *(const f32x4a*)(wp + i * 8), w1 = *(const f32x4a*)(wp + i * 8 + 4);
            const f32x4a a = v[2 * i], c = v[2 * i + 1]; u32x4 ov;
            ov[0] = cvtpk(a[0] * rinv * w0[0] * bf2f((unsigned short)(gq[0] & 0xffff)), a[1] * rinv * w0[1] * bf2f((unsigned short)(gq[0] >> 16)));
            ov[1] = cvtpk(a[2] * rinv * w0[2] * bf2f((unsigned short)(gq[1] & 0xffff)), a[3] * rinv * w0[3] * bf2f((unsigned short)(gq[1] >> 16)));
            ov[2] = cvtpk(c[0] * rinv * w1[0] * bf2f((unsigned short)(gq[2] & 0xffff)), c[1] * rinv * w1[1] * bf2f((unsigned short)(gq[2] >> 16)));
            ov[3] = cvtpk(c[2] * rinv * w1[2] * bf2f((unsigned short)(gq[3] & 0xffff)), c[3] * rinv * w1[3] * bf2f((unsigned short)(gq[3] >> 16)));
            *(u32x4*)(op + i * 8) = ov;
        }
    }
    ATT_LBAR();
#undef ATT_DMA
}
}
namespace gla {
#define GLAS __attribute__((address_space(3)))
using att::bf16x8; using att::s16x4; using att::f32x16; using att::f32x4a; using att::u32x4; using att::bf16raw; using att::cvtpk; using att::bf2f; using att::crow; using att::vtr;
typedef unsigned u32x2g __attribute__((ext_vector_type(2)));
__device__ __forceinline__ unsigned short f2bf(float f) { const unsigned u = __float_as_uint(f); return (unsigned short)((u + 0x7fffu + ((u >> 16) & 1u)) >> 16); }
__device__ __forceinline__ void prep_item(int item, const bf16raw* proj, const float* w2, const float* gb, bf16raw* kdecT, float* decay, GLAS char* sh3) {
    const int tid = threadIdx.x; const int c = item & 31, h = (item >> 5) & 3, b = item >> 7;
    const size_t m0 = (size_t)b * 2048 + c * 64;
    GLAS float* glr = (GLAS float*)sh3;
    GLAS float* segtot = glr + 1024;
    if (tid < 128) { const int t = tid >> 1, hf = tid & 1; const u32x4 g = *(const u32x4*)(proj + (m0 + t) * PITCH + 7168 + 8 * hf);
#pragma unroll
        for (int j = 0; j < 4; ++j) { glr[t * 16 + 8 * hf + 2 * j] = bf2f((unsigned short)(g[j] & 0xffff)); glr[t * 16 + 8 * hf + 2 * j + 1] = bf2f((unsigned short)(g[j] >> 16)); } }
    __syncthreads();
    const int k = tid & 127, seg = tid >> 7;
    float w[16];
#pragma unroll
    for (int r = 0; r < 16; ++r) w[r] = w2[r * 512 + h * 128 + k];
    const float bias = gb[h * 128 + k];
    float bb[16]; float cum = 0.f;
#pragma unroll
    for (int tt = 0; tt < 16; ++tt) { const int t = 16 * seg + tt; float z = bias;
#pragma unroll
        for (int r = 0; r < 16; ++r) z += glr[t * 16 + r] * w[r];
        const float la = (fminf(z, 0.f) - log1pf(expf(-fabsf(z)))) * (1.0f / 16.0f); cum += la; bb[tt] = cum; }
    segtot[seg * 128 + k] = cum;
    __syncthreads();
    float off = 0.f, tot = 0.f;
#pragma unroll
    for (int s = 0; s < 4; ++s) { const float v = segtot[s * 128 + k]; tot += v; if (s < seg) off += v; }
    unsigned short kd[16];
#pragma unroll
    for (int tt = 0; tt < 16; ++tt) { const int t = 16 * seg + tt; const float gk = bf2f(proj[(m0 + t) * PITCH + 4608 + h * 128 + k]);
        kd[(tt & 3) | ((tt & 4) << 1) | ((tt & 8) >> 1)] = f2bf(gk * expf(tot - (bb[tt] + off))); }
    u32x4 o0, o1;
#pragma unroll
    for (int j = 0; j < 4; ++j) { o0[j] = (unsigned)kd[2 * j] | ((unsigned)kd[2 * j + 1] << 16); o1[j] = (unsigned)kd[8 + 2 * j] | ((unsigned)kd[8 + 2 * j + 1] << 16); }
    bf16raw* dst = kdecT + (size_t)item * 8192 + k * 64 + 16 * seg;
    *(u32x4*)dst = o0; *(u32x4*)(dst + 8) = o1;
    if (seg == 0) decay[(size_t)(b * 32 + c) * 512 + h * 128 + k] = expf(tot);
    __syncthreads();
}
constexpr int LDS_VP = 0, LDS_OB = 32768, OSTR = 260;
__device__ __forceinline__ void scan_bh(int b, int h, const bf16raw* proj, const bf16raw* kdecT, const float* decay, const float* gnw, bf16raw* mix, GLAS char* sh3) {
    const int tid = threadIdx.x, lane = tid & 63, r32 = lane & 31, hi = lane >> 5; const int wid = __builtin_amdgcn_readfirstlane(tid >> 6);
    const int v0 = 32 * wid;
    f32x16 S[4];
#pragma unroll
    for (int i = 0; i < 4; ++i) S[i] = f32x16{};
    GLAS char* vpw = sh3 + LDS_VP + wid * 4096;
    const GLAS char* vrd = vpw + ((lane >> 4) & 1) * 32 + (lane & 3) * 8 + (4 * hi + ((lane & 15) >> 2)) * 64;
    GLAS float* ob = (GLAS float*)(sh3 + LDS_OB);
    const f32x4a gw4 = *(const f32x4a*)(gnw + 4 * lane);
    for (int c = 0; c < 32; ++c) {
        const size_t m0 = (size_t)b * 2048 + c * 64; const int item = (b * 4 + h) * 32 + c;
#pragma unroll
        for (int ks = 0; ks < 4; ++ks) { const u32x4 vv = *(const u32x4*)(proj + (m0 + 16 * ks + (lane >> 2)) * PITCH + 5120 + h * 256 + v0 + (lane & 3) * 8);
            *(GLAS u32x4*)(vpw + ks * 1024 + lane * 16) = vv; }
        const float* dc = decay + (size_t)(b * 32 + c) * 512 + h * 128 + 4 * hi;
#pragma unroll
        for (int kb = 0; kb < 4; ++kb)
#pragma unroll
            for (int g = 0; g < 4; ++g) { const f32x4a d4 = *(const f32x4a*)(dc + kb * 32 + 8 * g);
#pragma unroll
                for (int i = 0; i < 4; ++i) S[kb][4 * g + i] *= d4[i]; }
        const bf16raw* kt = kdecT + (size_t)item * 8192 + r32 * 64 + 8 * hi;
#pragma unroll
        for (int s = 0; s < 4; ++s) {
            const s16x4 lo = vtr(vrd + s * 1024), hh = vtr(vrd + s * 1024 + 512);
            const bf16x8 vf = (bf16x8){lo[0], lo[1], lo[2], lo[3], hh[0], hh[1], hh[2], hh[3]};
#pragma unroll
            for (int kb = 0; kb < 4; ++kb) { const bf16x8 af = *(const bf16x8*)(kt + kb * 32 * 64 + 16 * s);
                S[kb] = __builtin_amdgcn_mfma_f32_32x32x16_bf16(af, vf, S[kb], 0, 0, 0); }
        }
        f32x16 o[2]; o[0] = f32x16{}; o[1] = f32x16{};
        const bf16raw* qp = proj + (m0 + r32) * PITCH + 4096 + h * 128 + 8 * hi;
#pragma unroll
        for (int kb = 0; kb < 4; ++kb)
#pragma unroll
            for (int s2 = 0; s2 < 2; ++s2) {
                u32x4 sb;
#pragma unroll
                for (int i = 0; i < 4; ++i) sb[i] = cvtpk(S[kb][8 * s2 + 2 * i], S[kb][8 * s2 + 2 * i + 1]);
                const bf16x8 q0 = *(const bf16x8*)(qp + kb * 32 + 16 * s2), q1 = *(const bf16x8*)(qp + (size_t)32 * PITCH + kb * 32 + 16 * s2);
                o[0] = __builtin_amdgcn_mfma_f32_32x32x16_bf16(q0, __builtin_bit_cast(bf16x8, sb), o[0], 0, 0, 0);
                o[1] = __builtin_amdgcn_mfma_f32_32x32x16_bf16(q1, __builtin_bit_cast(bf16x8, sb), o[1], 0, 0, 0);
            }
#pragma unroll
        for (int tb = 0; tb < 2; ++tb)
#pragma unroll
            for (int r = 0; r < 16; ++r) ob[(tb * 32 + crow(r, hi)) * OSTR + v0 + r32] = o[tb][r];
        __syncthreads();
#pragma unroll
        for (int j = 0; j < 8; ++j) {
            const int t = 8 * wid + j; const f32x4a x4 = *(const GLAS f32x4a*)(ob + t * OSTR + 4 * lane);
            float ss = (x4[0] * x4[0] + x4[1] * x4[1]) + (x4[2] * x4[2] + x4[3] * x4[3]);
#pragma unroll
            for (int of = 1; of < 64; of <<= 1) ss += __shfl_xor(ss, of);
            const float rinv = 1.0f / sqrtf(ss * (1.0f / 256.0f) + 1e-6f);
            const u32x2g gg = *(const u32x2g*)(proj + (m0 + t) * PITCH + 6144 + h * 256 + 4 * lane);
            u32x2g ov; ov.x = cvtpk(x4[0] * rinv * gw4[0] * bf2f((unsigned short)(gg.x & 0xffff)), x4[1] * rinv * gw4[1] * bf2f((unsigned short)(gg.x >> 16)));
            ov.y = cvtpk(x4[2] * rinv * gw4[2] * bf2f((unsigned short)(gg.y & 0xffff)), x4[3] * rinv * gw4[3] * bf2f((unsigned short)(gg.y >> 16)));
            *(u32x2g*)(mix + (m0 + t) * 2048 + 1024 + h * 256 + 4 * lane) = ov;
        }
        __syncthreads();
    }
}
}
constexpr int NWAVES = 8;
constexpr int BATCH = 4, SEQ = 2048, DM = 2048, M = BATCH * SEQ, NPROJ = 7184;
constexpr float NORM_EPS = 1e-6f;
constexpr size_t MiB = 1u << 20;
constexpr size_t WS_CTL = 0, CTL_ZERO_BYTES = 1 * MiB;
constexpr size_t WS_MODP = 1 * MiB;
constexpr size_t WS_MOD = 4 * MiB;
constexpr size_t WS_ROPE = 5 * MiB;
constexpr size_t WS_DECAY = 6 * MiB;
constexpr size_t WS_WOUT = 8 * MiB;
constexpr size_t WS_WIN = 16 * MiB;
constexpr size_t WS_HN = 46 * MiB;
constexpr size_t WS_PROJ = 78 * MiB;
constexpr size_t WS_KDEC = 194 * MiB;
constexpr size_t WS_MIX = 202 * MiB;
constexpr size_t WS_END = 234 * MiB;
static_assert(WS_WIN + (size_t)PITCH * 2048 * 2 <= WS_HN && WS_PROJ + (size_t)M * PITCH * 2 <= WS_KDEC && WS_END <= 256 * MiB, "d_ws map");
constexpr int CW_BAR = 4096;
constexpr int CW_ROWSS = 65536;
static_assert((CW_ROWSS + 8192) * 4 <= (int)CTL_ZERO_BYTES, "ctl");
constexpr int RING_BYTES = 131072, LDSCTL_OFF = RING_BYTES, MISC_OFF = LDSCTL_OFF + 320, LDS_BYTES = 147456;
#define GAS __attribute__((address_space(1)))
#define LAS __attribute__((address_space(3)))
typedef unsigned short bf16;
typedef unsigned v4u __attribute__((ext_vector_type(4)));
typedef float f32x4 __attribute__((ext_vector_type(4)));
typedef short bf16x8 __attribute__((ext_vector_type(8)));
typedef GAS unsigned gu32;
typedef GAS unsigned long long gu64;
#define RLX_AGENT __ATOMIC_RELAXED, __HIP_MEMORY_SCOPE_AGENT
#define LDS_WAIT() asm volatile("s_waitcnt lgkmcnt(0)" ::: "memory")
#define VM_WAIT() asm volatile("s_waitcnt vmcnt(0)" ::: "memory")
__device__ __forceinline__ unsigned long long rt() { return __builtin_amdgcn_s_memrealtime(); }
__device__ __forceinline__ unsigned f2bf(float f) { unsigned u = __builtin_bit_cast(unsigned, f); return (u + 0x7fffu + ((u >> 16) & 1u)) >> 16; }
__device__ __forceinline__ unsigned pk2(float lo, float hi) { return f2bf(lo) | (f2bf(hi) << 16); }

#define XB_TMO      128
#define XB_XCNT(j)  (256  + 64 * (j))
#define XB_XSUB(j)  (1280 + 64 * (j))
#define XB_XGEN(j)  (2304 + 64 * (j))
#define XB_TOP      3328
#define XB_TOPGEN   3392
#define XCD_BAR_WORDS 3456
#define XB_SPIN_CAP (1u << 18)

__device__ __forceinline__ unsigned xb_ld(unsigned* p)              { return __hip_atomic_load(p, __ATOMIC_RELAXED, __HIP_MEMORY_SCOPE_AGENT); }
__device__ __forceinline__ unsigned xb_add(unsigned* p, unsigned v) { return __hip_atomic_fetch_add(p, v, __ATOMIC_RELAXED, __HIP_MEMORY_SCOPE_AGENT); }
__device__ __forceinline__ unsigned xb_xcc_id() { return (unsigned)__builtin_amdgcn_s_getreg((3 << 11) | 20) & 0xFu; }
#define XB_SPIN(cond, bar) do { unsigned _sp = 0; while (cond) { __builtin_amdgcn_s_sleep(1); \
    if ((++_sp & 255u) == 0u) { if (xb_ld(&(bar)[XB_TMO])) break; if (_sp > XB_SPIN_CAP) { atomicAdd(&(bar)[XB_TMO], 1u); break; } } } } while (0)

struct XcdBarrier {
    unsigned* bar; unsigned x;
    volatile LAS unsigned* st;
};

__device__ __forceinline__ XcdBarrier xcd_barrier_post(unsigned* bar, volatile LAS unsigned* st) {
    XcdBarrier b; b.bar = bar; b.x = xb_xcc_id(); b.st = st;
    if (threadIdx.x == 0) (void)xb_add(&bar[XB_XCNT(b.x)], 1u);
    return b;
}
__device__ __forceinline__ void xcd_barrier_complete(unsigned* bar, unsigned x, unsigned& nloc, unsigned& nx) {
    const unsigned G = gridDim.x * gridDim.y * gridDim.z;
    unsigned sum, cnt, mine, sp = 0u;
    for (;;) {
        sum = 0u; cnt = 0u; mine = 0u;
#pragma unroll
        for (unsigned j = 0; j < 16; ++j) { const unsigned c = xb_ld(&bar[XB_XCNT(j)]); sum += c; cnt += (c > 0u) ? 1u : 0u; mine = (j == x) ? c : mine; }
        if (sum == G) break;
        __builtin_amdgcn_s_sleep(1);
        if ((++sp & 255u) == 0u) { if (xb_ld(&bar[XB_TMO])) break; if (sp > XB_SPIN_CAP) { atomicAdd(&bar[XB_TMO], 1u); break; } }
    }
    nloc = mine > 0u ? mine : 1u; nx = cnt > 0u ? cnt : 1u;
}

__device__ __forceinline__ void xcd_barrier(const XcdBarrier& b) {
    asm volatile("s_waitcnt vmcnt(0)" ::: "memory");
    __syncthreads();
    if (threadIdx.x == 0) {
        unsigned* bar = b.bar;
        __builtin_amdgcn_s_waitcnt(0);
        unsigned nloc = b.st[0], nx = b.st[1];
        if (nloc == 0u) { xcd_barrier_complete(bar, b.x, nloc, nx); b.st[0] = nloc; b.st[1] = nx; }
        const unsigned old = xb_add(&bar[XB_XSUB(b.x)], 1u);
        const unsigned gen = old / nloc;
        if (old + 1u == (gen + 1u) * nloc) {
            __builtin_amdgcn_fence(__ATOMIC_RELEASE, "agent");
            asm volatile("s_waitcnt vmcnt(0)" ::: "memory");
            const unsigned og = xb_add(&bar[XB_TOP], 1u);
            const unsigned tg = og / nx;
            if (og + 1u == (tg + 1u) * nx) xb_add(&bar[XB_TOPGEN], 1u);
            else XB_SPIN(xb_ld(&bar[XB_TOPGEN]) == tg, bar);
            __builtin_amdgcn_fence(__ATOMIC_ACQUIRE, "agent");
            xb_add(&bar[XB_XGEN(b.x)], 1u);
            asm volatile("s_waitcnt vmcnt(0)" ::: "memory");
        } else {
            XB_SPIN(xb_ld(&bar[XB_XGEN(b.x)]) == gen, bar);
            __builtin_amdgcn_fence(__ATOMIC_ACQUIRE, "agent");
            asm volatile("s_waitcnt vmcnt(0)" ::: "memory");
        }
    }
    __syncthreads();
}
struct Frame {
    LAS unsigned char* lds; volatile LAS unsigned* MISC; gu32* ctl;
    int tid, lane, wave, vcu, G;
    const float *x, *c, *norm_w, *w_ada, *b_ada, *w_in, *lq1, *lk1, *lq2, *lk2, *dnw, *w2, *gb, *gnw, *w_out, *fnw;
    float* out;
    float *modp, *mod, *rope, *decay, *rowss;
    bf16 *Win_t, *Wout_t, *HN, *PROJ, *KDEC, *MIX;
};
__device__ __forceinline__ float wave_sum(float v) {
#pragma unroll
    for (int o = 1; o < 64; o <<= 1) v += __shfl_xor(v, o);
    return v;
}
__device__ __forceinline__ void p0_transpose_item(const float* W, int K, int N, int ldw, bf16* WT, LAS float* scr, int kb, int nb, int lane) {
    const int k0 = 64 * kb, n0 = 32 * nb; const int nn = n0 + (lane & 31); const bool ok = nn < N;
#pragma unroll 8
    for (int i = 0; i < 32; ++i) { const int kk = 2 * i + (lane >> 5); scr[kk * 33 + (lane & 31)] = ok ? W[(size_t)(k0 + kk) * ldw + nn] : 0.f; }
    LDS_WAIT(); asm volatile("" ::: "memory");
    const int c = lane & 7;
#pragma unroll
    for (int j = 0; j < 4; ++j) { const int n = (lane >> 3) + 8 * j; const LAS float* s = scr + (8 * c) * 33 + n;
        v4u o; o.x = pk2(s[0 * 33], s[1 * 33]); o.y = pk2(s[2 * 33], s[3 * 33]); o.z = pk2(s[4 * 33], s[5 * 33]); o.w = pk2(s[6 * 33], s[7 * 33]);
        *(GAS v4u*)(WT + (size_t)(n0 + n) * K + k0 + 8 * c) = o; }
    LDS_WAIT(); asm volatile("" ::: "memory");
}
__device__ __forceinline__ void p0_ada_item(Frame& F, LAS float* scr, int item) {
    const int ks = item / 24, cg = item % 24;
#pragma unroll
    for (int b = 0; b < 4; ++b) { const float cv = F.c[b * 2048 + 64 * ks + F.lane]; scr[b * 64 + F.lane] = cv / (1.0f + expf(-cv)); }
    LDS_WAIT(); asm volatile("" ::: "memory");
    const float* wp = F.w_ada + (size_t)(64 * ks) * 6144 + 256 * cg + 4 * F.lane;
    f32x4 a0 = {0.f, 0.f, 0.f, 0.f}, a1 = a0, a2 = a0, a3 = a0;
#pragma unroll 8
    for (int kk = 0; kk < 64; ++kk) { const f32x4 w = *(const GAS f32x4*)(wp + (size_t)kk * 6144);
        a0 += scr[kk] * w; a1 += scr[64 + kk] * w; a2 += scr[128 + kk] * w; a3 += scr[192 + kk] * w; }
    float* op = F.modp + (size_t)(ks * 4) * 6144 + 256 * cg + 4 * F.lane;
    *(GAS f32x4*)(op) = a0; *(GAS f32x4*)(op + 6144) = a1; *(GAS f32x4*)(op + 2 * 6144) = a2; *(GAS f32x4*)(op + 3 * 6144) = a3;
    LDS_WAIT(); asm volatile("" ::: "memory");
}
__device__ __forceinline__ void p0_rope_item(Frame& F, int r) {
    const int e = r * 64 + F.lane, pos = e >> 5, i = e & 31;
    const double inv = pow(10000.0, -(double)i / 32.0); const double ang = (double)pos * inv;
    F.rope[2 * e] = (float)cos(ang); F.rope[2 * e + 1] = (float)sin(ang);
}
__device__ __forceinline__ void p0_prologue(Frame& F) {
    LAS float* scr = (LAS float*)(F.lds + F.wave * 16384);
    const int gw = F.vcu * NWAVES + F.wave, NGW = F.G * NWAVES;
    constexpr int I_ADA = 32 * 24, I_IN = 32 * 232, I_OUT = 32 * 64, I_ROPE = 1024, NITEMS = I_ADA + I_IN + I_OUT + I_ROPE;
    for (int it = gw; it < NITEMS; it += NGW) {
        int r = it;
        if (r < I_ADA) { p0_ada_item(F, scr, r); continue; } r -= I_ADA;
        if (r < I_IN) { p0_transpose_item(F.w_in, 2048, NPROJ, NPROJ, F.Win_t, scr, r / 232, r % 232, F.lane); continue; } r -= I_IN;
        if (r < I_OUT) { p0_transpose_item(F.w_out, 2048, 2048, 2048, F.Wout_t, scr, r / 64, r % 64, F.lane); continue; } r -= I_OUT;
        p0_rope_item(F, r);
    }
}
__device__ __forceinline__ void p1_hn(Frame& F) {
    LAS f32x4* gs = (LAS f32x4*)F.lds; LAS f32x4* sh = gs + 512;
    const int w = F.vcu, b = w >> 6; const bool writer = (w & 63) == 0;
    for (int s = F.tid; s < (writer ? 1536 : 1024); s += NWAVES * 64) {
        f32x4 a = *(const GAS f32x4*)(F.b_ada + 4 * s);
#pragma unroll 8
        for (int ks = 0; ks < 32; ++ks) a += *(const GAS f32x4*)(F.modp + (size_t)(ks * 4 + b) * 6144 + 4 * s);
        if (s < 512) sh[s] = a; else if (s < 1024) { const f32x4 nw = *(const GAS f32x4*)(F.norm_w + 4 * (s - 512)); gs[s - 512] = nw * (1.0f + a); }
        if (writer) *(GAS f32x4*)(F.mod + (size_t)b * 6144 + 4 * s) = a;
    }
    __syncthreads();
#pragma unroll 1
    for (int r = 0; r < 4; ++r) {
        const int row = 32 * w + 4 * F.wave + r;
        const GAS f32x4* xr = (const GAS f32x4*)(F.x + (size_t)row * 2048) + F.lane;
        f32x4 v[8]; float s = 0.f;
#pragma unroll
        for (int j = 0; j < 8; ++j) { v[j] = xr[64 * j]; s += (v[j].x * v[j].x + v[j].y * v[j].y) + (v[j].z * v[j].z + v[j].w * v[j].w); }
        const float rinv = 1.0f / sqrtf(wave_sum(s) * (1.0f / 2048.0f) + NORM_EPS);
        GAS unsigned long long* o8 = (GAS unsigned long long*)(F.HN + (size_t)row * 2048) + F.lane;
#pragma unroll
        for (int j = 0; j < 8; ++j) { const f32x4 g = gs[F.lane + 64 * j], sf = sh[F.lane + 64 * j]; const f32x4 y = v[j] * rinv * g + sf;
            o8[64 * j] = (unsigned long long)pk2(y.x, y.y) | ((unsigned long long)pk2(y.z, y.w) << 32); }
    }
}
__device__ __forceinline__ void p6_final(Frame& F) {
    const int gw = F.vcu * NWAVES + F.wave, NGW = F.G * NWAVES;
    for (int row = gw; row < M; row += NGW) {
        const float rinv = 1.0f / sqrtf(F.rowss[row] * (1.0f / 2048.0f) + NORM_EPS);
        GAS f32x4* xr = (GAS f32x4*)(F.out + (size_t)row * 2048) + F.lane;
#pragma unroll
        for (int j = 0; j < 8; ++j) { const f32x4 v = xr[64 * j], wv = *(const GAS f32x4*)(F.fnw + 4 * (F.lane + 64 * j)); xr[64 * j] = v * rinv * wv; }
    }
}

constexpr int NPH = 7;
struct Args { const float* in[16]; float* out; unsigned char* ws; int ph_lo, ph_hi, li, pad; };
__global__ void __launch_bounds__(NWAVES * 64, 2) mega_fwd(Args args) {
    extern __shared__ __attribute__((aligned(16))) unsigned char lds[];
    Frame F;
    F.lds = (LAS unsigned char*)lds; F.MISC = (volatile LAS unsigned*)(F.lds + MISC_OFF);
    F.tid = threadIdx.x; F.lane = F.tid & 63; F.wave = __builtin_amdgcn_readfirstlane(F.tid >> 6);
    F.G = gridDim.x; { const int bx = blockIdx.x; F.vcu = (F.G % 8 == 0) ? (bx % 8) * (F.G / 8) + bx / 8 : bx; }
    unsigned char* ws = args.ws;
    F.ctl = (gu32*)(ws + WS_CTL);
    F.x = args.in[0]; F.c = args.in[1]; F.norm_w = args.in[2]; F.w_ada = args.in[3]; F.b_ada = args.in[4]; F.w_in = args.in[5];
    F.lq1 = args.in[6]; F.lk1 = args.in[7]; F.lq2 = args.in[8]; F.lk2 = args.in[9]; F.dnw = args.in[10]; F.w2 = args.in[11]; F.gb = args.in[12]; F.gnw = args.in[13];
    F.w_out = args.in[14]; F.fnw = args.in[15]; F.out = args.out;
    F.modp = (float*)(ws + WS_MODP); F.mod = (float*)(ws + WS_MOD); F.rope = (float*)(ws + WS_ROPE); F.decay = (float*)(ws + WS_DECAY); F.rowss = (float*)(ws + WS_CTL) + CW_ROWSS;
    F.Win_t = (bf16*)(ws + WS_WIN); F.Wout_t = (bf16*)(ws + WS_WOUT); F.HN = (bf16*)(ws + WS_HN); F.PROJ = (bf16*)(ws + WS_PROJ); F.KDEC = (bf16*)(ws + WS_KDEC); F.MIX = (bf16*)(ws + WS_MIX);
    for (int u = F.tid; u < (LDS_BYTES - LDSCTL_OFF) / 4; u += NWAVES * 64) ((LAS unsigned*)(F.lds + LDSCTL_OFF))[u] = 0u;
    __syncthreads();
    const int lo = args.ph_lo, hi = args.ph_hi;
    const bool use_bar = (hi - lo) > 1;
    XcdBarrier bar; bar.bar = (unsigned*)(F.ctl + CW_BAR) + args.li * XCD_BAR_WORDS; bar.x = 0; bar.st = nullptr;
    if (use_bar) bar = xcd_barrier_post((unsigned*)(F.ctl + CW_BAR) + args.li * XCD_BAR_WORDS, F.MISC + 8);
#define IN(k) (lo <= (k) && (k) < hi)
#define SEAM(k) do { if (IN(k) && IN((k) + 1)) xcd_barrier(bar); } while (0)

    if (IN(0)) { p0_prologue(F); SEAM(0); }
    if (IN(1)) { p1_hn(F); SEAM(1); }
    if (IN(2)) {
        pg8::Gemm g{F.HN, F.Win_t, M, PITCH, 2048}; pg8::StaticOrder S; S.init(M, PITCH, F.G, (int)blockIdx.x);
        pg8::EpiProj E{F.PROJ, F.rope};
        pg8::gemm_phase<pg8::EpiProj, pg8::StaticOrder, true, true>(F.lds, g, S, E);
        SEAM(2);
    }
    if (IN(3)) {
        for (int it = F.vcu; it < 512; it += F.G) gla::prep_item(it, F.PROJ, F.w2, F.gb, F.KDEC, F.decay, (LAS char*)F.lds);
        SEAM(3);
    }
    if (IN(4)) {
        const float lam = expf(wave_sum(F.lq1[F.lane] * F.lk1[F.lane])) - expf(wave_sum(F.lq2[F.lane] * F.lk2[F.lane])) + 0.2f;
        for (int v = F.vcu; v < 256; v += F.G) { const int bh = v >> 3, s = v & 7;
            att::attn_unit(bh >> 3, bh & 7, 15 - s, F.PROJ, F.MIX, F.dnw, lam, (LAS char*)F.lds);
            att::attn_unit(bh >> 3, bh & 7, s, F.PROJ, F.MIX, F.dnw, lam, (LAS char*)F.lds); }
        for (int v = F.vcu; v < 256; v += F.G) if ((v & 15) == 0) { const int bh = v >> 4; gla::scan_bh(bh >> 2, bh & 3, F.PROJ, F.KDEC, F.decay, F.gnw, F.MIX, (LAS char*)F.lds); }
        SEAM(4);
    }
    if (IN(5)) {
        pg8::Gemm g{F.MIX, F.Wout_t, M, 2048, 2048}; pg8::StaticOrder S; S.init(M, 2048, F.G, (int)blockIdx.x);
        pg8::EpiOut E{F.x, F.out, F.mod, F.rowss};
        pg8::gemm_phase<pg8::EpiOut, pg8::StaticOrder, true, true>(F.lds, g, S, E);
        SEAM(5);
    }
    if (IN(6)) p6_final(F);
#undef IN
#undef SEAM
}

#ifndef MK_CUTS
#define MK_CUTS {0, 7}
#endif
extern "C" void kernel_launch(void* const* d_in, const int* in_sizes, int n_in, void* d_out, int out_size, void* d_ws, size_t ws_size, hipStream_t stream) {
    static int grid = 0;
    if (grid == 0) {
        if (n_in != 16 || out_size != M * DM || ws_size < WS_END) { fprintf(stderr, "kernel_launch: unexpected problem (n_in %d, out %d, ws %zu)\n", n_in, out_size, ws_size); grid = -1; return; }
        int dev = 0, cus = 0, per_cu = 0;
        if (hipGetDevice(&dev) != hipSuccess || hipDeviceGetAttribute(&cus, hipDeviceAttributeMultiprocessorCount, dev) != hipSuccess) { grid = -1; return; }
        if (hipFuncSetAttribute((const void*)mega_fwd, hipFuncAttributeMaxDynamicSharedMemorySize, LDS_BYTES) != hipSuccess) { fprintf(stderr, "kernel_launch: hipFuncSetAttribute failed\n"); grid = -1; return; }
        if (hipOccupancyMaxActiveBlocksPerMultiprocessor(&per_cu, (const void*)mega_fwd, NWAVES * 64, LDS_BYTES) != hipSuccess || per_cu < 1) fprintf(stderr, "kernel_launch: occupancy query says %d\n", per_cu);
        (void)hipGetLastError();
        grid = cus;
    }
    if (grid < 0) return;
    (void)hipMemsetAsync((char*)d_ws + WS_CTL, 0, CTL_ZERO_BYTES, stream);
    Args a{};
    for (int i = 0; i < 16; ++i) a.in[i] = (const float*)d_in[i];
    a.out = (float*)d_out; a.ws = (unsigned char*)d_ws;
    const int cuts[] = MK_CUTS; const int nl = (int)(sizeof(cuts) / sizeof(int)) - 1;
    for (int li = 0; li < nl; ++li) {
        a.ph_lo = cuts[li]; a.ph_hi = cuts[li + 1]; a.li = li; a.pad = 0;
        hipLaunchKernelGGL(mega_fwd, dim3(grid), dim3(NWAVES * 64), LDS_BYTES, stream, a);
    }
}
```

```cpp
#include <hip/hip_runtime.h>
#include <hip/hip_bf16.h>
#include <cstdio>
#include <cstdint>
#include <cmath>
constexpr int PITCH = 7424;
namespace pg8 {
#define PG8_LAS __attribute__((address_space(3)))
typedef unsigned short bf16_t;
typedef short bf16x8 __attribute__((ext_vector_type(8)));
typedef float f32x4 __attribute__((ext_vector_type(4)));
typedef unsigned u32x4 __attribute__((ext_vector_type(4)));
constexpr int BM = 256, BK = 64, HALF = 128, HTB = HALF * BK * 2  , STAGE_BYTES = 8 * HTB, NXCD = 8, WGM = 8;

__host__ __device__ __forceinline__ int lds_byte(int r, int c) { const int st = (r >> 4) * 2 + (c >> 5), rr = r & 15, cc = c & 31, ob = rr * 64 + cc * 2; return st * 1024 + (ob ^ (((ob >> 9) & 1) << 5)); }
__host__ __device__ __forceinline__ void stage_rc(int b, int& R, int& C) { const int st = b / 1024, sb = b % 1024, swz = sb ^ (((sb >> 9) & 1) << 5); R = (st >> 1) * 16 + swz / 64; C = (st & 1) * 32 + (swz % 64) / 2; }
__host__ __device__ __forceinline__ int perm32(int rho) { const int n = rho >> 4, i = rho & 15; return 8 * (i >> 2) + 4 * n + (i & 3); }

struct Unit { int pm, pn; };
struct Gemm { const bf16_t* A; const bf16_t* Bt; int M, N, K; };

struct StaticOrder {
    int nM, nN, nwg, G, c;
    __host__ __device__ void init(int M, int N, int G_, int c_) { nM = M / BM; nN = N / BM; nwg = nM * nN; G = G_; c = c_; }
    __host__ __device__ bool next(int i, Unit& u) const {
        const long L = (long)i * G + c; if (L >= nwg) return false;
        int wgid = (int)L; { const int q = nwg / NXCD, r = nwg % NXCD, xcd = wgid % NXCD, off = wgid / NXCD; wgid = (xcd < r ? xcd * (q + 1) : r * (q + 1) + (xcd - r) * q) + off; }
        const int nig = WGM * nN, gid = wgid / nig, fm = gid * WGM, gsz = (nM - fm) < WGM ? (nM - fm) : WGM;
        u.pm = fm + ((wgid % nig) % gsz); u.pn = (wgid % nig) / gsz; return true;
    }
    __device__ __forceinline__ void a_ready(const Unit&) const {}
    __device__ __forceinline__ void done(const Unit&) const {}
};
__device__ __forceinline__ unsigned cvt_pk_bf16(float lo, float hi) { unsigned r; asm volatile("v_cvt_pk_bf16_f32 %0, %1, %2" : "=v"(r) : "v"(lo), "v"(hi)); return r; }
typedef float f32x2 __attribute__((ext_vector_type(2)));
typedef unsigned u32x2 __attribute__((ext_vector_type(2)));
__device__ __forceinline__ float fast_silu(float v) { return v * __builtin_amdgcn_rcpf(1.0f + __builtin_amdgcn_exp2f(-1.4426950408889634f * v)); }
struct EpiProj {
    static constexpr int PERM = 2; static constexpr bool AFTER_DRAIN = false;
    bf16_t* P; const float* rope;
    template <int MODE> __device__ __forceinline__ void run(const f32x4 (&acc)[2][2][4][2], int row0, int cb, int dsub) const {
#pragma unroll
        for (int ai = 0; ai < 2; ++ai)
#pragma unroll
            for (int m = 0; m < 4; ++m) {
                const int row = row0 + ai * HALF + m * 16;
                bf16_t* rowp = P + (size_t)row * PITCH + cb;
                f32x4 c4 = {0.f, 0.f, 0.f, 0.f}, s4 = {0.f, 0.f, 0.f, 0.f};
                if (MODE <= 1) { const f32x4* rp = (const f32x4*)(rope + ((size_t)(row & 2047) * 32 + dsub) * 2); const f32x4 t0 = rp[0], t1 = rp[1];
                    c4 = (f32x4){t0[0], t0[2], t1[0], t1[2]}; s4 = (f32x4){t0[1], t0[3], t1[1], t1[3]}; }
#pragma unroll
                for (int bj = 0; bj < 2; ++bj) {
                    f32x4 x1 = acc[ai][bj][m][0], x2 = acc[ai][bj][m][1];
                    if (MODE <= 1) { f32x4 o1 = x1 * c4 - x2 * s4, o2 = x2 * c4 + x1 * s4; if (MODE == 0) { o1 = o1 * 0.18033688011112042f; o2 = o2 * 0.18033688011112042f; } x1 = o1; x2 = o2; }
                    else if (MODE == 2) {
#pragma unroll
                        for (int i = 0; i < 4; ++i) { x1[i] = fast_silu(x1[i]); x2[i] = fast_silu(x2[i]); } }
                    else if (MODE == 3) { x1 = x1 * 0.08838834764831845f; x2 = x2 * 0.08838834764831845f; }
                    u32x2 w1, w2; w1.x = cvt_pk_bf16(x1[0], x1[1]); w1.y = cvt_pk_bf16(x1[2], x1[3]); w2.x = cvt_pk_bf16(x2[0], x2[1]); w2.y = cvt_pk_bf16(x2[2], x2[3]);
                    *(u32x2*)(rowp + bj * HALF) = w1; *(u32x2*)(rowp + bj * HALF + 32) = w2;
                }
            }
    }
    __device__ __forceinline__ void operator()(const f32x4 (&acc)[2][2][4][2], const Unit& u, int wr, int wc, int fr, int fq) const {
        const int pn = u.pn, row0 = u.pm * BM + wr * 64 + fr, dsub = 16 * (wc & 1) + 4 * fq;
        const int cb = pn * BM + 64 * (wc >> 1) + dsub;
        if (pn < 4) run<0>(acc, row0, cb, dsub);
        else if (pn < 8) run<1>(acc, row0, cb, dsub);
        else if ((pn >= 12 && pn < 16) || (pn >= 24 && pn < 28)) run<2>(acc, row0, cb, dsub);
        else if (pn == 16 || pn == 17) run<3>(acc, row0, cb, dsub);
        else run<4>(acc, row0, cb, dsub);
    }
};
struct EpiOut {
    static constexpr int PERM = 0; static constexpr bool AFTER_DRAIN = false;
    const float* x; float* out; const float* mod; float* rowss;
    __device__ __forceinline__ void operator()(const f32x4 (&acc)[2][2][4][2], const Unit& u, int wr, int wc, int fr, int fq) const {
        const int row0 = u.pm * BM + wr * 64 + fr, col0 = u.pn * BM + wc * 32 + 4 * fq, b = (u.pm * BM) >> 11;
        f32x4 g[2][2];
#pragma unroll
        for (int bj = 0; bj < 2; ++bj)
#pragma unroll
            for (int n = 0; n < 2; ++n) g[bj][n] = *(const f32x4*)(mod + b * 6144 + 4096 + col0 + bj * HALF + n * 16);
#pragma unroll
        for (int ai = 0; ai < 2; ++ai)
#pragma unroll
            for (int m = 0; m < 4; ++m) {
                const int row = row0 + ai * HALF + m * 16; const size_t rp = (size_t)row * 2048 + col0; float ss = 0.f;
#pragma unroll
                for (int bj = 0; bj < 2; ++bj)
#pragma unroll
                    for (int n = 0; n < 2; ++n) { const f32x4 xv = *(const f32x4*)(x + rp + bj * HALF + n * 16); const f32x4 hv = xv + g[bj][n] * acc[ai][bj][m][n];
                        *(f32x4*)(out + rp + bj * HALF + n * 16) = hv; ss += (hv[0] * hv[0] + hv[1] * hv[1]) + (hv[2] * hv[2] + hv[3] * hv[3]); }
                ss += __shfl_xor(ss, 16); ss += __shfl_xor(ss, 32);
                if (fq == 0) atomicAdd(rowss + row, ss);
            }
    }
};
template <class Epi, class Sched, bool ALIGN_EPI = false, bool SP2 = false>
__device__ __forceinline__ void gemm_phase(PG8_LAS unsigned char* lds, const Gemm g, const Sched& S, const Epi& E) {
    const int tid = threadIdx.x, wid = __builtin_amdgcn_readfirstlane(tid >> 6), lane = tid & 63, wr = wid >> 2, wc = wid & 3, fr = lane & 15, fq = lane >> 4;
    const int K = g.K, nt = K / BK;
    unsigned voffA[2], voffB[2];
#pragma unroll
    for (int i = 0; i < 2; ++i) { int R, C; stage_rc(tid * 16 + i * 8192, R, C); const int Rb = Epi::PERM == 1 ? ((R & ~31) + perm32(R & 31)) : Epi::PERM == 2 ? ((R & ~48) | ((R & 16) << 1) | ((R & 32) >> 1)) : R;
        voffA[i] = (unsigned)(R * K + C) * 2u; voffB[i] = (unsigned)(Rb * K + C) * 2u; }
    const size_t kstep = (size_t)(BK * 2);
    const size_t hstep = (size_t)HALF * K * 2;
    const size_t tstep = 2 * hstep;
    const unsigned ldsw = (unsigned)wid * 1024u;
    const int aoff = lds_byte(wr * 64 + fr, fq * 8), boff = lds_byte(wc * 32 + fr, fq * 8);
#define PG8_SA(b, h) (((b) * 2 + (h)) * HTB)
#define PG8_SB(b, h) ((4 + (b) * 2 + (h)) * HTB)
#define PG8_STAGE(bufoff, gbase, voff) do { _Pragma("unroll") for (int _i = 0; _i < 2; ++_i) \
        __builtin_amdgcn_global_load_lds((const unsigned*)((const char*)(gbase) + (voff)[_i]), (PG8_LAS unsigned*)(lds + (bufoff) + ldsw + _i * 8192), 16, 0, 0); } while (0)
#define PG8_LDA(dst, b, h) do { _Pragma("unroll") for (int m = 0; m < 4; ++m) _Pragma("unroll") for (int k = 0; k < 2; ++k) dst[m][k] = *(const PG8_LAS bf16x8*)(lds + PG8_SA(b, h) + aoff + m * 2048 + k * 1024); } while (0)
#define PG8_LDB(dst, b, h) do { _Pragma("unroll") for (int n = 0; n < 2; ++n) _Pragma("unroll") for (int k = 0; k < 2; ++k) dst[n][k] = *(const PG8_LAS bf16x8*)(lds + PG8_SB(b, h) + boff + n * 2048 + k * 1024); } while (0)
#define PG8_MMA(ai, bj, At, Bt) do { __builtin_amdgcn_s_setprio(1); _Pragma("unroll") for (int m = 0; m < 4; ++m) _Pragma("unroll") for (int n = 0; n < 2; ++n) _Pragma("unroll") for (int k = 0; k < 2; ++k) \
        acc[ai][bj][m][n] = __builtin_amdgcn_mfma_f32_16x16x32_bf16(Bt[n][k], At[m][k], acc[ai][bj][m][n], 0, 0, 0); __builtin_amdgcn_s_setprio(0); } while (0)
#define PG8_WAIT_V(n) asm volatile("s_waitcnt vmcnt(" #n ")" ::: "memory")
#define PG8_WAIT_L(n) asm volatile("s_waitcnt lgkmcnt(" #n ")" ::: "memory")
#define PG8_BAR __builtin_amdgcn_s_barrier()
#define PG8_SCHED __builtin_amdgcn_sched_barrier(0)
    Unit cur, nxt; int ui = 0;
    if (!S.next(0, cur)) return;
    f32x4 acc[2][2][4][2];
#pragma unroll
    for (int a = 0; a < 2; ++a)
#pragma unroll
        for (int b = 0; b < 2; ++b)
#pragma unroll
            for (int m = 0; m < 4; ++m)
#pragma unroll
                for (int n = 0; n < 2; ++n) acc[a][b][m][n] = (f32x4){0.f, 0.f, 0.f, 0.f};
    bf16x8 At[4][2], B0[2][2], B1[2][2];
    const char* cA = (const char*)g.A + (size_t)cur.pm * tstep; const char* cB = (const char*)g.Bt + (size_t)cur.pn * tstep;
    S.a_ready(cur);
    if constexpr (SP2) {
        PG8_STAGE(PG8_SB(0, 0), cB, voffB); PG8_STAGE(PG8_SB(0, 1), cB + hstep, voffB); PG8_STAGE(PG8_SA(0, 0), cA, voffA); PG8_STAGE(PG8_SA(0, 1), cA + hstep, voffA);
        if (wr == 1) PG8_BAR;
        PG8_WAIT_V(2); PG8_BAR;
        PG8_STAGE(PG8_SB(1, 0), cB + kstep, voffB); PG8_STAGE(PG8_SA(1, 0), cA + kstep, voffA); PG8_STAGE(PG8_SB(1, 1), cB + hstep + kstep, voffB);
        PG8_WAIT_V(6); PG8_BAR;
    } else {
        PG8_STAGE(PG8_SB(0, 0), cB, voffB); PG8_STAGE(PG8_SA(0, 0), cA, voffA); PG8_STAGE(PG8_SB(0, 1), cB + hstep, voffB); PG8_STAGE(PG8_SA(0, 1), cA + hstep, voffA);
        if (wr == 1) PG8_BAR;
        PG8_WAIT_V(4); PG8_BAR;
        PG8_STAGE(PG8_SB(1, 0), cB + kstep, voffB); PG8_STAGE(PG8_SA(1, 0), cA + kstep, voffA); PG8_STAGE(PG8_SB(1, 1), cB + hstep + kstep, voffB);
        PG8_WAIT_V(6); PG8_BAR;
    }
    for (;;) {
        const bool has_next = S.next(ui + 1, nxt);
        const char* nA = has_next ? (const char*)g.A + (size_t)nxt.pm * tstep : cA; const char* nB = has_next ? (const char*)g.Bt + (size_t)nxt.pn * tstep : cB;
        for (int t = 0; t < nt; t += 2) {
            const bool last = (t == nt - 2);
            const char* a1 = cA + (size_t)(t + 1) * kstep;
            const char* a2 = last ? nA : cA + (size_t)(t + 2) * kstep; const char* b2 = last ? nB : cB + (size_t)(t + 2) * kstep;
            const char* a3 = a2 + kstep; const char* b3 = b2 + kstep;
            if (last && has_next) S.a_ready(nxt);
            if constexpr (SP2) {
            PG8_LDB(B0, 0, 0); PG8_LDB(B1, 0, 1); PG8_SCHED; PG8_LDA(At, 0, 0); PG8_STAGE(PG8_SA(1, 1), a1 + hstep, voffA);
            PG8_WAIT_V(8); PG8_WAIT_L(0); PG8_BAR; PG8_MMA(0, 0, At, B0); PG8_MMA(0, 1, At, B1); PG8_BAR; PG8_SCHED;
            PG8_LDA(At, 0, 1); PG8_STAGE(PG8_SB(0, 0), b2, voffB); PG8_STAGE(PG8_SB(0, 1), b2 + hstep, voffB); PG8_STAGE(PG8_SA(0, 0), a2, voffA);
            PG8_WAIT_V(8); PG8_WAIT_L(0); PG8_BAR; PG8_MMA(1, 0, At, B0); PG8_MMA(1, 1, At, B1); PG8_BAR; PG8_SCHED;
            PG8_LDB(B0, 1, 0); PG8_LDB(B1, 1, 1); PG8_SCHED; PG8_LDA(At, 1, 0); PG8_STAGE(PG8_SA(0, 1), a2 + hstep, voffA);
            PG8_WAIT_V(8); PG8_WAIT_L(0); PG8_BAR; PG8_MMA(0, 0, At, B0); PG8_MMA(0, 1, At, B1); PG8_BAR; PG8_SCHED;
            PG8_LDA(At, 1, 1); PG8_STAGE(PG8_SB(1, 0), b3, voffB); PG8_STAGE(PG8_SB(1, 1), b3 + hstep, voffB); PG8_STAGE(PG8_SA(1, 0), a3, voffA);
            PG8_WAIT_V(8); PG8_WAIT_L(0); PG8_BAR; PG8_MMA(1, 0, At, B0); PG8_MMA(1, 1, At, B1); PG8_BAR; PG8_SCHED;
            } else {
            PG8_LDB(B0, 0, 0); PG8_SCHED; PG8_LDA(At, 0, 0); PG8_STAGE(PG8_SA(1, 1), a1 + hstep, voffA);
            PG8_WAIT_L(8); PG8_BAR; PG8_WAIT_L(0); PG8_MMA(0, 0, At, B0); PG8_BAR; PG8_SCHED;
            PG8_LDB(B1, 0, 1); PG8_STAGE(PG8_SB(0, 0), b2, voffB);
            PG8_BAR; PG8_WAIT_L(0); PG8_MMA(0, 1, At, B1); PG8_BAR;
            PG8_LDA(At, 0, 1); PG8_STAGE(PG8_SA(0, 0), a2, voffA);
            PG8_BAR; PG8_WAIT_L(0); PG8_MMA(1, 0, At, B0); PG8_BAR; PG8_SCHED;
            PG8_STAGE(PG8_SB(0, 1), b2 + hstep, voffB);
            PG8_WAIT_V(6); PG8_BAR; PG8_MMA(1, 1, At, B1); PG8_BAR;
            PG8_LDB(B0, 1, 0); PG8_SCHED; PG8_LDA(At, 1, 0); PG8_STAGE(PG8_SA(0, 1), a2 + hstep, voffA);
            PG8_WAIT_L(8); PG8_BAR; PG8_WAIT_L(0); PG8_MMA(0, 0, At, B0); PG8_BAR; PG8_SCHED;
            PG8_LDB(B1, 1, 1); PG8_STAGE(PG8_SB(1, 0), b3, voffB);
            PG8_BAR; PG8_WAIT_L(0); PG8_MMA(0, 1, At, B1); PG8_BAR;
            PG8_LDA(At, 1, 1); PG8_STAGE(PG8_SA(1, 0), a3, voffA);
            PG8_BAR; PG8_WAIT_L(0); PG8_MMA(1, 0, At, B0); PG8_BAR; PG8_SCHED;
            PG8_STAGE(PG8_SB(1, 1), b3 + hstep, voffB);
            PG8_WAIT_V(6); PG8_BAR; PG8_MMA(1, 1, At, B1); PG8_BAR;
            }
        }
        if constexpr (ALIGN_EPI) { if (wr == 0) PG8_BAR; }
        if constexpr (!Epi::AFTER_DRAIN) { E(acc, cur, wr, wc, fr, fq); S.done(cur); }
        if (!has_next) break;
#pragma unroll
        for (int a = 0; a < 2; ++a)
#pragma unroll
            for (int b = 0; b < 2; ++b)
#pragma unroll
                for (int m = 0; m < 4; ++m)
#pragma unroll
                    for (int n = 0; n < 2; ++n) acc[a][b][m][n] = (f32x4){0.f, 0.f, 0.f, 0.f};
        cur = nxt; cA = nA; cB = nB; ++ui;
        if constexpr (ALIGN_EPI) { if (wr == 1) PG8_BAR; }
    }
    PG8_WAIT_V(0);
    if constexpr (!ALIGN_EPI) { if (wr == 0) PG8_BAR; }
    PG8_BAR;
    if constexpr (Epi::AFTER_DRAIN) { E.fused(acc, cur, wr, wc, fr, fq, lds, wid, lane); S.done(cur); }
#undef PG8_SA
#undef PG8_SB
#undef PG8_STAGE
#undef PG8_LDA
#undef PG8_LDB
#undef PG8_MMA
#undef PG8_WAIT_V
#undef PG8_WAIT_L
#undef PG8_BAR
#undef PG8_SCHED
}
}
namespace att {
#define ALAS __attribute__((address_space(3)))
using bf16x8 = __attribute__((ext_vector_type(8))) short;
using s16x4 = __attribute__((ext_vector_type(4))) short;
using f32x16 = __attribute__((ext_vector_type(16))) float;
using f32x4a = __attribute__((ext_vector_type(4))) float;
using u32x4 = __attribute__((ext_vector_type(4))) unsigned;
typedef short v4i16_t __attribute__((ext_vector_type(4)));
typedef unsigned short bf16raw;
constexpr int LDS_K = 0, LDS_V = 32768, TILEB = 16384, LDS_X = 0, XSTR = 132, LDS_WS = 69632, LDS_BYTES = LDS_WS + 8 * 256;
__device__ __forceinline__ int crow(int r, int hi) { return (r & 3) + 8 * (r >> 2) + 4 * hi; }
__device__ __forceinline__ void glds16(const void* gsrc, unsigned lds_dst) { unsigned keep;
    asm volatile("s_mov_b32 %0, m0\n\ts_mov_b32 m0, %2\n\ts_nop 0\n\tglobal_load_lds_dwordx4 %1, off\n\ts_mov_b32 m0, %0" : "=&s"(keep) : "v"(gsrc), "s"(lds_dst) : "memory"); }
typedef float f32x2_t __attribute__((ext_vector_type(2))); typedef __bf16 bf16x2_t __attribute__((ext_vector_type(2)));
__device__ __forceinline__ unsigned cvtpk(float lo, float hi) { f32x2_t v = {lo, hi}; bf16x2_t b = __builtin_convertvector(v, bf16x2_t); return __builtin_bit_cast(unsigned, b); }
__device__ __forceinline__ float bf2f(unsigned short u) { return __uint_as_float((unsigned)u << 16); }
__device__ __forceinline__ s16x4 vtr(const ALAS char* p) { return __builtin_bit_cast(s16x4, __builtin_amdgcn_ds_read_tr16_b64_v4i16((ALAS v4i16_t*)p)); }
#define ATT_WAITBAR() asm volatile("s_waitcnt vmcnt(0) lgkmcnt(0)\n\ts_barrier" ::: "memory")
#define ATT_LBAR() asm volatile("s_waitcnt lgkmcnt(0)\n\ts_barrier" ::: "memory")
__device__ __forceinline__ float halfswap_max(float m) { auto rr = __builtin_amdgcn_permlane32_swap(__float_as_uint(m), __float_as_uint(m), false, false); return fmaxf(__uint_as_float(rr[0]), __uint_as_float(rr[1])); }
__device__ __forceinline__ float halfswap_add(float m) { auto rr = __builtin_amdgcn_permlane32_swap(__float_as_uint(m), __float_as_uint(m), false, false); return __uint_as_float(rr[0]) + __uint_as_float(rr[1]); }

__device__ __forceinline__ void attn_unit(int b, int h, int qb2, const bf16raw* proj, bf16raw* mix, const float* dnw, float lam, ALAS char* sh3) {
    const int tid = threadIdx.x, lane = tid & 63, r32 = lane & 31, hi = lane >> 5; const int wid = __builtin_amdgcn_readfirstlane(tid >> 6);
    const int rg = wid >> 1, comp = wid & 1;
    const long rowbase = (long)b * 2048; const int q0 = qb2 * 128;
    const int NT = 2 * qb2 + 2, myNT = 2 * qb2 + 1 + (rg >> 1);
    const unsigned lds0 = (unsigned)(uintptr_t)sh3;
    ALAS float* wsf = (ALAS float*)(sh3 + LDS_WS) + wid * 64;
    const bf16raw* Qw = proj + (rowbase + q0 + rg * 32 + r32) * PITCH + h * 128 + comp * 64 + hi * 8;
    bf16x8 qr[4];
#pragma unroll
    for (int d0 = 0; d0 < 4; ++d0) qr[d0] = *(const bf16x8*)(Qw + d0 * 16);
    const bf16raw* ksrc = proj + (rowbase + lane) * PITCH + 1024 + h * 128 + (2 * wid) * 8;
    const bf16raw* vsrc = proj + (rowbase + 32 * (wid & 1) + (lane >> 2)) * PITCH + 2048 + h * 128 + (wid >> 1) * 32 + (lane & 3) * 8;
    const unsigned kdst = lds0 + LDS_K + (2 * wid) * 1024, vdst = lds0 + LDS_V + (2 * wid) * 1024;
#define ATT_DMA(t, buf) do { const bf16raw* ks_ = ksrc + (long)(t) * 64 * PITCH; const bf16raw* vs_ = vsrc + (long)(t) * 64 * PITCH; const unsigned bo_ = (unsigned)(buf) * TILEB; \
        glds16(ks_, (unsigned)__builtin_amdgcn_readfirstlane(kdst + bo_)); glds16(ks_ + 8, (unsigned)__builtin_amdgcn_readfirstlane(kdst + bo_ + 1024)); \
        glds16(vs_, (unsigned)__builtin_amdgcn_readfirstlane(vdst + bo_)); glds16(vs_ + 16 * PITCH, (unsigned)__builtin_amdgcn_readfirstlane(vdst + bo_ + 1024)); } while (0)
    float mrun = 0.f, l = 0.f;
    f32x16 o[4];
#pragma unroll
    for (int d = 0; d < 4; ++d) o[d] = f32x16{};
    const ALAS char* kp0 = sh3 + LDS_K + (comp * 8 + hi) * 1024 + r32 * 16;
    const ALAS char* vp0 = sh3 + LDS_V + ((lane >> 4) & 1) * 32 + (lane & 3) * 8 + (4 * hi + ((lane & 15) >> 2)) * 64;
    ATT_DMA(0, 0);
    for (int t = 0; t < NT; ++t) {
        const int buf = t & 1;
        ATT_WAITBAR();
        if (t + 1 < NT) ATT_DMA(t + 1, buf ^ 1);
        if (t < myNT) {
            const ALAS char* kp = kp0 + buf * TILEB; const ALAS char* vp = vp0 + buf * TILEB;
            f32x16 p0 = f32x16{}, p1 = f32x16{};
#pragma unroll
            for (int d0 = 0; d0 < 4; ++d0) {
                const bf16x8 a0 = *(const ALAS bf16x8*)(kp + d0 * 2048), a1 = *(const ALAS bf16x8*)(kp + d0 * 2048 + 512);
                p0 = __builtin_amdgcn_mfma_f32_32x32x16_bf16(a0, qr[d0], p0, 0, 0, 0);
                p1 = __builtin_amdgcn_mfma_f32_32x32x16_bf16(a1, qr[d0], p1, 0, 0, 0);
            }
            float rm = fmaxf(p0[0], p1[0]);
#pragma unroll
            for (int r = 1; r < 16; ++r) rm = fmaxf(rm, fmaxf(p0[r], p1[r]));
            rm = halfswap_max(rm);
            if (t == 0) mrun = rm;
            else if (__any(rm > mrun + 8.0f)) {
                const float mn = fmaxf(mrun, rm), f = __builtin_amdgcn_exp2f(mrun - mn); mrun = mn; l *= f;
                if (hi == 0) wsf[r32] = f;
                asm volatile("s_waitcnt lgkmcnt(0)" ::: "memory");
#pragma unroll
                for (int r = 0; r < 16; ++r) { const float fr_ = wsf[crow(r, hi)];
#pragma unroll
                    for (int d = 0; d < 4; ++d) o[d][r] *= fr_; }
            }
            float sacc = 0.f;
#pragma unroll
            for (int r = 0; r < 16; ++r) { p0[r] = __builtin_amdgcn_exp2f(p0[r] - mrun); p1[r] = __builtin_amdgcn_exp2f(p1[r] - mrun); sacc += p0[r] + p1[r]; }
            l += sacc;
            u32x4 pw[4];
#pragma unroll
            for (int i = 0; i < 4; ++i) { pw[0][i] = cvtpk(p0[2 * i], p0[2 * i + 1]); pw[1][i] = cvtpk(p0[8 + 2 * i], p0[8 + 2 * i + 1]); pw[2][i] = cvtpk(p1[2 * i], p1[2 * i + 1]); pw[3][i] = cvtpk(p1[8 + 2 * i], p1[8 + 2 * i + 1]); }
#pragma unroll
            for (int d0 = 0; d0 < 4; ++d0)
#pragma unroll
                for (int ks = 0; ks < 4; ++ks) {
                    const s16x4 lo = vtr(vp + (d0 * 4 + ks) * 1024), hh = vtr(vp + (d0 * 4 + ks) * 1024 + 512);
                    const bf16x8 vf = (bf16x8){lo[0], lo[1], lo[2], lo[3], hh[0], hh[1], hh[2], hh[3]};
                    o[d0] = __builtin_amdgcn_mfma_f32_32x32x16_bf16(__builtin_bit_cast(bf16x8, pw[ks]), vf, o[d0], 0, 0, 0);
                }
        }
    }
    l = halfswap_add(l);
    if (hi == 0) wsf[r32] = (comp ? lam : 1.0f) / l;
    asm volatile("s_waitcnt lgkmcnt(0)" ::: "memory");
    float rli[16];
#pragma unroll
    for (int r = 0; r < 16; ++r) rli[r] = wsf[crow(r, hi)];
    ATT_WAITBAR();
    ALAS float* X = (ALAS float*)(sh3 + LDS_X) + rg * 32 * XSTR;
    if (comp == 1) {
#pragma unroll
        for (int d = 0; d < 4; ++d)
#pragma unroll
            for (int r = 0; r < 16; ++r) X[crow(r, hi) * XSTR + d * 32 + r32] = o[d][r] * rli[r];
    }
    ATT_LBAR();
    if (comp == 0) {
#pragma unroll
        for (int d = 0; d < 4; ++d)
#pragma unroll
            for (int r = 0; r < 16; ++r) { const int ix = crow(r, hi) * XSTR + d * 32 + r32; X[ix] = o[d][r] * rli[r] - X[ix]; }
    }
    ATT_LBAR();
    {
        const int row = 16 * comp + (lane >> 2), seg = lane & 3;
        const ALAS f32x4a* xr = (const ALAS f32x4a*)(X + row * XSTR + seg * 32);
        f32x4a v[8]; float ss = 0.f;
#pragma unroll
        for (int i = 0; i < 8; ++i) { v[i] = xr[i]; ss += (v[i][0] * v[i][0] + v[i][1] * v[i][1]) + (v[i][2] * v[i][2] + v[i][3] * v[i][3]); }
        ss += __shfl_xor(ss, 1); ss += __shfl_xor(ss, 2);
        const float rinv = 0.8f / sqrtf(ss * (1.0f / 128.0f) + 1e-6f);
        const long m = rowbase + q0 + rg * 32 + row;
        const bf16raw* gp = proj + m * PITCH + 3072 + h * 128 + seg * 32;
        bf16raw* op = mix + m * 2048 + h * 128 + seg * 32;
        const float* wp = dnw + seg * 32;
#pragma unroll
        for (int i = 0; i < 4; ++i) {
            const u32x4 gq = *(const u32x4*)(gp + i * 8); const f32x4a w0 = *(const f32x4a*)(wp + i * 8), w1 = *(const f32x4a*)(wp + i * 8 + 4);
            const f32x4a a = v[2 * i], c = v[2 * i + 1]; u32x4 ov;
            ov[0] = cvtpk(a[0] * rinv * w0[0] * bf2f((unsigned short)(gq[0] & 0xffff)), a[1] * rinv * w0[1] * bf2f((unsigned short)(gq[0] >> 16)));
            ov[1] = cvtpk(a[2] * rinv * w0[2] * bf2f((unsigned short)(gq[1] & 0xffff)), a[3] * rinv * w0[3] * bf2f((unsigned short)(gq[1] >> 16)));
            ov[2] = cvtpk(c[0] * rinv * w1[0] * bf2f((unsigned short)(gq[2] & 0xffff)), c[1] * rinv * w1[1] * bf2f((unsigned short)(gq[2] >> 16)));
            ov[3] = cvtpk(c[2] * rinv * w1[2] * bf2f((unsigned short)(gq[3] & 0xffff)), c[3] * rinv * w1[3] * bf2f((unsigned short)(gq[3] >> 16)));
            *(u32x4*)(op + i * 8) = ov;
        }
    }
    ATT_LBAR();
#undef ATT_DMA
}
}
namespace gla {
#define GLAS __attribute__((address_space(3)))
using att::bf16x8; using att::s16x4; using att::f32x16; using att::f32x4a; using att::u32x4; using att::bf16raw; using att::cvtpk; using att::bf2f; using att::crow; using att::vtr;
typedef unsigned u32x2g __attribute__((ext_vector_type(2)));
__device__ __forceinline__ unsigned short f2bf(float f) { const unsigned u = __float_as_uint(f); return (unsigned short)((u + 0x7fffu + ((u >> 16) & 1u)) >> 16); }
constexpr int L_GLR = 0, L_SEG = 4096, L_KD = 8192, KDSTR = 144, L_VP = 32768;
__device__ __forceinline__ void prepU_item(int item, const bf16raw* proj, const float* w2, const float* gb, bf16raw* UT, float* decay, GLAS char* sh3) {
    const int tid = threadIdx.x, lane = tid & 63, r32 = lane & 31, hi = lane >> 5; const int wid = __builtin_amdgcn_readfirstlane(tid >> 6);
    const int c = item & 31, h = (item >> 5) & 3, b = item >> 7;
    const size_t m0 = (size_t)b * 2048 + c * 64;
    GLAS float* glr = (GLAS float*)(sh3 + L_GLR); GLAS float* segtot = (GLAS float*)(sh3 + L_SEG);
    const int v0 = 32 * wid; GLAS char* vpw = sh3 + L_VP + wid * 4096;
#pragma unroll
    for (int ks = 0; ks < 4; ++ks) { const u32x4 vv = *(const u32x4*)(proj + (m0 + 16 * ks + (lane >> 2)) * PITCH + 5120 + h * 256 + v0 + (lane & 3) * 8);
        *(GLAS u32x4*)(vpw + ks * 1024 + lane * 16) = vv; }
    if (tid < 128) { const int t = tid >> 1, hf = tid & 1; const u32x4 g = *(const u32x4*)(proj + (m0 + t) * PITCH + 7168 + 8 * hf);
#pragma unroll
        for (int j = 0; j < 4; ++j) { glr[t * 16 + 8 * hf + 2 * j] = bf2f((unsigned short)(g[j] & 0xffff)); glr[t * 16 + 8 * hf + 2 * j + 1] = bf2f((unsigned short)(g[j] >> 16)); } }
    __syncthreads();
    const int k = tid & 127, seg = tid >> 7;
    float w[16];
#pragma unroll
    for (int r = 0; r < 16; ++r) w[r] = w2[r * 512 + h * 128 + k];
    const float bias = gb[h * 128 + k];
    float bb[16]; float cum = 0.f;
#pragma unroll
    for (int tt = 0; tt < 16; ++tt) { const int t = 16 * seg + tt; float z = bias;
#pragma unroll
        for (int r = 0; r < 16; ++r) z += glr[t * 16 + r] * w[r];
        const float la = (fminf(z, 0.f) - log1pf(expf(-fabsf(z)))) * (1.0f / 16.0f); cum += la; bb[tt] = cum; }
    segtot[seg * 128 + k] = cum;
    __syncthreads();
    float off = 0.f, tot = 0.f;
#pragma unroll
    for (int s = 0; s < 4; ++s) { const float v = segtot[s * 128 + k]; tot += v; if (s < seg) off += v; }
    unsigned short kd[16];
#pragma unroll
    for (int tt = 0; tt < 16; ++tt) { const int t = 16 * seg + tt; const float gk = bf2f(proj[(m0 + t) * PITCH + 4608 + h * 128 + k]);
        kd[(tt & 3) | ((tt & 4) << 1) | ((tt & 8) >> 1)] = f2bf(gk * expf(tot - (bb[tt] + off))); }
    u32x4 o0, o1;
#pragma unroll
    for (int j = 0; j < 4; ++j) { o0[j] = (unsigned)kd[2 * j] | ((unsigned)kd[2 * j + 1] << 16); o1[j] = (unsigned)kd[8 + 2 * j] | ((unsigned)kd[8 + 2 * j + 1] << 16); }
    GLAS char* kdl = sh3 + L_KD + k * KDSTR + seg * 32;
    *(GLAS u32x4*)kdl = o0; *(GLAS u32x4*)(kdl + 16) = o1;
    if (seg == 0) decay[(size_t)(b * 32 + c) * 512 + h * 128 + k] = expf(tot);
    __syncthreads();
    f32x16 D[4];
#pragma unroll
    for (int i = 0; i < 4; ++i) D[i] = f32x16{};
    const GLAS char* vrd = vpw + ((lane >> 4) & 1) * 32 + (lane & 3) * 8 + (4 * hi + ((lane & 15) >> 2)) * 64;
    const GLAS char* kar = sh3 + L_KD + r32 * KDSTR + 16 * hi;
#pragma unroll
    for (int s = 0; s < 4; ++s) {
        const s16x4 lo = vtr(vrd + s * 1024), hh = vtr(vrd + s * 1024 + 512);
        const bf16x8 vf = (bf16x8){lo[0], lo[1], lo[2], lo[3], hh[0], hh[1], hh[2], hh[3]};
#pragma unroll
        for (int kb = 0; kb < 4; ++kb) { const bf16x8 af = *(const GLAS bf16x8*)(kar + kb * 32 * KDSTR + 32 * s);
            D[kb] = __builtin_amdgcn_mfma_f32_32x32x16_bf16(af, vf, D[kb], 0, 0, 0); }
    }
    bf16raw* up = UT + ((size_t)item * 256 + v0 + r32) * 128 + 4 * hi;
#pragma unroll
    for (int kb = 0; kb < 4; ++kb)
#pragma unroll
        for (int g = 0; g < 4; ++g) { u32x2g pk; pk.x = cvtpk(D[kb][4 * g], D[kb][4 * g + 1]); pk.y = cvtpk(D[kb][4 * g + 2], D[kb][4 * g + 3]); *(u32x2g*)(up + kb * 32 + 8 * g) = pk; }
    __syncthreads();
}
__device__ __forceinline__ void scan_elem(int g, bf16raw* UT, const float* decay) {
    const int bh = g >> 13, v = (g >> 5) & 255, k = 4 * (g & 31), b = bh >> 2, h = bh & 3;
    bf16raw* up = UT + ((size_t)(bh * 32) * 256 + v) * 128 + k;
    const float* dp = decay + (size_t)(b * 32) * 512 + h * 128 + k;
    f32x4a S = {0.f, 0.f, 0.f, 0.f};
#pragma unroll 8
    for (int c = 0; c < 32; ++c) {
        const u32x2g u = *(const u32x2g*)(up + (size_t)c * 32768); const f32x4a d = *(const f32x4a*)(dp + c * 512);
        S[0] = d[0] * S[0] + bf2f((unsigned short)(u.x & 0xffff)); S[1] = d[1] * S[1] + bf2f((unsigned short)(u.x >> 16));
        S[2] = d[2] * S[2] + bf2f((unsigned short)(u.y & 0xffff)); S[3] = d[3] * S[3] + bf2f((unsigned short)(u.y >> 16));
        u32x2g o; o.x = cvtpk(S[0], S[1]); o.y = cvtpk(S[2], S[3]);
        *(u32x2g*)(up + (size_t)c * 32768) = o;
    }
}
constexpr int L_OB = 0, OSTR = 260;
__device__ __forceinline__ void o_item(int item, const bf16raw* proj, const bf16raw* ST, const float* gnw, bf16raw* mix, GLAS char* sh3) {
    const int tid = threadIdx.x, lane = tid & 63, r32 = lane & 31, hi = lane >> 5; const int wid = __builtin_amdgcn_readfirstlane(tid >> 6);
    const int c = item & 31, h = (item >> 5) & 3, b = item >> 7; const int v0 = 32 * wid;
    const size_t m0 = (size_t)b * 2048 + c * 64;
    f32x16 o[2]; o[0] = f32x16{}; o[1] = f32x16{};
    const bf16raw* sp = ST + ((size_t)item * 256 + v0 + r32) * 128 + 8 * hi;
    const bf16raw* qp = proj + (m0 + r32) * PITCH + 4096 + h * 128 + 8 * hi;
#pragma unroll
    for (int ks = 0; ks < 8; ++ks) {
        const bf16x8 sf = *(const bf16x8*)(sp + 16 * ks), q0 = *(const bf16x8*)(qp + 16 * ks), q1 = *(const bf16x8*)(qp + (size_t)32 * PITCH + 16 * ks);
        o[0] = __builtin_amdgcn_mfma_f32_32x32x16_bf16(q0, sf, o[0], 0, 0, 0);
        o[1] = __builtin_amdgcn_mfma_f32_32x32x16_bf16(q1, sf, o[1], 0, 0, 0);
    }
    GLAS float* ob = (GLAS float*)(sh3 + L_OB);
#pragma unroll
    for (int tb = 0; tb < 2; ++tb)
#pragma unroll
        for (int r = 0; r < 16; ++r) ob[(tb * 32 + crow(r, hi)) * OSTR + v0 + r32] = o[tb][r];
    __syncthreads();
    const f32x4a gw4 = *(const f32x4a*)(gnw + 4 * lane);
#pragma unroll
    for (int j = 0; j < 8; ++j) {
        const int t = 8 * wid + j; const f32x4a x4 = *(const GLAS f32x4a*)(ob + t * OSTR + 4 * lane);
        float ss = (x4[0] * x4[0] + x4[1] * x4[1]) + (x4[2] * x4[2] + x4[3] * x4[3]);
#pragma unroll
        for (int of = 1; of < 64; of <<= 1) ss += __shfl_xor(ss, of);
        const float rinv = 1.0f / sqrtf(ss * (1.0f / 256.0f) + 1e-6f);
        const u32x2g gg = *(const u32x2g*)(proj + (m0 + t) * PITCH + 6144 + h * 256 + 4 * lane);
        u32x2g ov; ov.x = cvtpk(x4[0] * rinv * gw4[0] * bf2f((unsigned short)(gg.x & 0xffff)), x4[1] * rinv * gw4[1] * bf2f((unsigned short)(gg.x >> 16)));
        ov.y = cvtpk(x4[2] * rinv * gw4[2] * bf2f((unsigned short)(gg.y & 0xffff)), x4[3] * rinv * gw4[3] * bf2f((unsigned short)(gg.y >> 16)));
        *(u32x2g*)(mix + (m0 + t) * 2048 + 1024 + h * 256 + 4 * lane) = ov;
    }
    __syncthreads();
}
}
constexpr int NWAVES = 8;
constexpr int BATCH = 4, SEQ = 2048, DM = 2048, M = BATCH * SEQ, NPROJ = 7184;
constexpr float NORM_EPS = 1e-6f;
constexpr size_t MiB = 1u << 20;
constexpr size_t WS_CTL = 0, CTL_ZERO_BYTES = 1 * MiB;
constexpr size_t WS_MODP = 1 * MiB;
constexpr size_t WS_MOD = 4 * MiB;
constexpr size_t WS_ROPE = 5 * MiB;
constexpr size_t WS_DECAY = 6 * MiB;
constexpr size_t WS_WOUT = 8 * MiB;
constexpr size_t WS_WIN = 16 * MiB;
constexpr size_t WS_HN = 46 * MiB;
constexpr size_t WS_PROJ = 78 * MiB;
constexpr size_t WS_KDEC = 194 * MiB;
constexpr size_t WS_MIX = 202 * MiB;
constexpr size_t WS_END = 234 * MiB;
static_assert(WS_WIN + (size_t)PITCH * 2048 * 2 <= WS_HN && WS_PROJ + (size_t)M * PITCH * 2 <= WS_KDEC && WS_END <= 256 * MiB, "d_ws map");
constexpr int CW_BAR = 4096;
constexpr int CW_ROWSS = 65536;
static_assert((CW_ROWSS + 8192) * 4 <= (int)CTL_ZERO_BYTES, "ctl");
constexpr int RING_BYTES = 131072, LDSCTL_OFF = RING_BYTES, MISC_OFF = LDSCTL_OFF + 320, LDS_BYTES = 147456;
#define GAS __attribute__((address_space(1)))
#define LAS __attribute__((address_space(3)))
typedef unsigned short bf16;
typedef unsigned v4u __attribute__((ext_vector_type(4)));
typedef float f32x4 __attribute__((ext_vector_type(4)));
typedef short bf16x8 __attribute__((ext_vector_type(8)));
typedef GAS unsigned gu32;
typedef GAS unsigned long long gu64;
#define RLX_AGENT __ATOMIC_RELAXED, __HIP_MEMORY_SCOPE_AGENT
#define LDS_WAIT() asm volatile("s_waitcnt lgkmcnt(0)" ::: "memory")
#define VM_WAIT() asm volatile("s_waitcnt vmcnt(0)" ::: "memory")
__device__ __forceinline__ unsigned long long rt() { return __builtin_amdgcn_s_memrealtime(); }
__device__ __forceinline__ unsigned f2bf(float f) { unsigned u = __builtin_bit_cast(unsigned, f); return (u + 0x7fffu + ((u >> 16) & 1u)) >> 16; }
__device__ __forceinline__ unsigned pk2(float lo, float hi) { return f2bf(lo) | (f2bf(hi) << 16); }

#define XB_TMO      128
#define XB_XCNT(j)  (256  + 64 * (j))
#define XB_XSUB(j)  (1280 + 64 * (j))
#define XB_XGEN(j)  (2304 + 64 * (j))
#define XB_TOP      3328
#define XB_TOPGEN   3392
#define XCD_BAR_WORDS 3456
#define XB_SPIN_CAP (1u << 18)

__device__ __forceinline__ unsigned xb_ld(unsigned* p)              { return __hip_atomic_load(p, __ATOMIC_RELAXED, __HIP_MEMORY_SCOPE_AGENT); }
__device__ __forceinline__ unsigned xb_add(unsigned* p, unsigned v) { return __hip_atomic_fetch_add(p, v, __ATOMIC_RELAXED, __HIP_MEMORY_SCOPE_AGENT); }
__device__ __forceinline__ unsigned xb_xcc_id() { return (unsigned)__builtin_amdgcn_s_getreg((3 << 11) | 20) & 0xFu; }
#define XB_SPIN(cond, bar) do { unsigned _sp = 0; while (cond) { __builtin_amdgcn_s_sleep(1); \
    if ((++_sp & 255u) == 0u) { if (xb_ld(&(bar)[XB_TMO])) break; if (_sp > XB_SPIN_CAP) { atomicAdd(&(bar)[XB_TMO], 1u); break; } } } } while (0)

struct XcdBarrier {
    unsigned* bar; unsigned x;
    volatile LAS unsigned* st;
};

__device__ __forceinline__ XcdBarrier xcd_barrier_post(unsigned* bar, volatile LAS unsigned* st) {
    XcdBarrier b; b.bar = bar; b.x = xb_xcc_id(); b.st = st;
    if (threadIdx.x == 0) (void)xb_add(&bar[XB_XCNT(b.x)], 1u);
    return b;
}
__device__ __forceinline__ void xcd_barrier_complete(unsigned* bar, unsigned x, unsigned& nloc, unsigned& nx) {
    const unsigned G = gridDim.x * gridDim.y * gridDim.z;
    unsigned sum, cnt, mine, sp = 0u;
    for (;;) {
        sum = 0u; cnt = 0u; mine = 0u;
#pragma unroll
        for (unsigned j = 0; j < 16; ++j) { const unsigned c = xb_ld(&bar[XB_XCNT(j)]); sum += c; cnt += (c > 0u) ? 1u : 0u; mine = (j == x) ? c : mine; }
        if (sum == G) break;
        __builtin_amdgcn_s_sleep(1);
        if ((++sp & 255u) == 0u) { if (xb_ld(&bar[XB_TMO])) break; if (sp > XB_SPIN_CAP) { atomicAdd(&bar[XB_TMO], 1u); break; } }
    }
    nloc = mine > 0u ? mine : 1u; nx = cnt > 0u ? cnt : 1u;
}

__device__ __forceinline__ void xcd_barrier(const XcdBarrier& b) {
    asm volatile("s_waitcnt vmcnt(0)" ::: "memory");
    __syncthreads();
    if (threadIdx.x == 0) {
        unsigned* bar = b.bar;
        __builtin_amdgcn_s_waitcnt(0);
        unsigned nloc = b.st[0], nx = b.st[1];
        if (nloc == 0u) { xcd_barrier_complete(bar, b.x, nloc, nx); b.st[0] = nloc; b.st[1] = nx; }
        const unsigned old = xb_add(&bar[XB_XSUB(b.x)], 1u);
        const unsigned gen = old / nloc;
        if (old + 1u == (gen + 1u) * nloc) {
            __builtin_amdgcn_fence(__ATOMIC_RELEASE, "agent");
            asm volatile("s_waitcnt vmcnt(0)" ::: "memory");
            const unsigned og = xb_add(&bar[XB_TOP], 1u);
            const unsigned tg = og / nx;
            if (og + 1u == (tg + 1u) * nx) xb_add(&bar[XB_TOPGEN], 1u);
            else XB_SPIN(xb_ld(&bar[XB_TOPGEN]) == tg, bar);
            __builtin_amdgcn_fence(__ATOMIC_ACQUIRE, "agent");
            xb_add(&bar[XB_XGEN(b.x)], 1u);
            asm volatile("s_waitcnt vmcnt(0)" ::: "memory");
        } else {
            XB_SPIN(xb_ld(&bar[XB_XGEN(b.x)]) == gen, bar);
            __builtin_amdgcn_fence(__ATOMIC_ACQUIRE, "agent");
            asm volatile("s_waitcnt vmcnt(0)" ::: "memory");
        }
    }
    __syncthreads();
}
struct Frame {
    LAS unsigned char* lds; volatile LAS unsigned* MISC; gu32* ctl;
    int tid, lane, wave, vcu, G;
    const float *x, *c, *norm_w, *w_ada, *b_ada, *w_in, *lq1, *lk1, *lq2, *lk2, *dnw, *w2, *gb, *gnw, *w_out, *fnw;
    float* out;
    float *modp, *mod, *rope, *decay, *rowss;
    bf16 *Win_t, *Wout_t, *HN, *PROJ, *UT, *MIX;
};
__device__ __forceinline__ float wave_sum(float v) {
#pragma unroll
    for (int o = 1; o < 64; o <<= 1) v += __shfl_xor(v, o);
    return v;
}
__device__ __forceinline__ void p0_transpose_item(const float* W, int K, int N, int ldw, bf16* WT, LAS float* scr, int kb, int nb, int lane) {
    const int k0 = 64 * kb, n0 = 32 * nb; const int nn = n0 + (lane & 31); const bool ok = nn < N;
#pragma unroll 8
    for (int i = 0; i < 32; ++i) { const int kk = 2 * i + (lane >> 5); scr[kk * 33 + (lane & 31)] = ok ? W[(size_t)(k0 + kk) * ldw + nn] : 0.f; }
    LDS_WAIT(); asm volatile("" ::: "memory");
    const int c = lane & 7;
#pragma unroll
    for (int j = 0; j < 4; ++j) { const int n = (lane >> 3) + 8 * j; const LAS float* s = scr + (8 * c) * 33 + n;
        v4u o; o.x = pk2(s[0 * 33], s[1 * 33]); o.y = pk2(s[2 * 33], s[3 * 33]); o.z = pk2(s[4 * 33], s[5 * 33]); o.w = pk2(s[6 * 33], s[7 * 33]);
        *(GAS v4u*)(WT + (size_t)(n0 + n) * K + k0 + 8 * c) = o; }
    LDS_WAIT(); asm volatile("" ::: "memory");
}
__device__ __forceinline__ void p0_ada_item(Frame& F, LAS float* scr, int item) {
    const int ks = item / 24, cg = item % 24;
#pragma unroll
    for (int b = 0; b < 4; ++b) { const float cv = F.c[b * 2048 + 64 * ks + F.lane]; scr[b * 64 + F.lane] = cv / (1.0f + expf(-cv)); }
    LDS_WAIT(); asm volatile("" ::: "memory");
    const float* wp = F.w_ada + (size_t)(64 * ks) * 6144 + 256 * cg + 4 * F.lane;
    f32x4 a0 = {0.f, 0.f, 0.f, 0.f}, a1 = a0, a2 = a0, a3 = a0;
#pragma unroll 8
    for (int kk = 0; kk < 64; ++kk) { const f32x4 w = *(const GAS f32x4*)(wp + (size_t)kk * 6144);
        a0 += scr[kk] * w; a1 += scr[64 + kk] * w; a2 += scr[128 + kk] * w; a3 += scr[192 + kk] * w; }
    float* op = F.modp + (size_t)(ks * 4) * 6144 + 256 * cg + 4 * F.lane;
    *(GAS f32x4*)(op) = a0; *(GAS f32x4*)(op + 6144) = a1; *(GAS f32x4*)(op + 2 * 6144) = a2; *(GAS f32x4*)(op + 3 * 6144) = a3;
    LDS_WAIT(); asm volatile("" ::: "memory");
}
__device__ __forceinline__ void p0_rope_item(Frame& F, int r) {
    const int e = r * 64 + F.lane, pos = e >> 5, i = e & 31;
    const double inv = pow(10000.0, -(double)i / 32.0); const double ang = (double)pos * inv;
    F.rope[2 * e] = (float)cos(ang); F.rope[2 * e + 1] = (float)sin(ang);
}
__device__ __forceinline__ void p0_prologue(Frame& F) {
    LAS float* scr = (LAS float*)(F.lds + F.wave * 16384);
    const int gw = F.vcu * NWAVES + F.wave, NGW = F.G * NWAVES;
    constexpr int I_ADA = 32 * 24, I_IN = 32 * 232, I_OUT = 32 * 64, I_ROPE = 1024, NITEMS = I_ADA + I_IN + I_OUT + I_ROPE;
    for (int it = gw; it < NITEMS; it += NGW) {
        int r = it;
        if (r < I_ADA) { p0_ada_item(F, scr, r); continue; } r -= I_ADA;
        if (r < I_IN) { p0_transpose_item(F.w_in, 2048, NPROJ, NPROJ, F.Win_t, scr, r / 232, r % 232, F.lane); continue; } r -= I_IN;
        if (r < I_OUT) { p0_transpose_item(F.w_out, 2048, 2048, 2048, F.Wout_t, scr, r / 64, r % 64, F.lane); continue; } r -= I_OUT;
        p0_rope_item(F, r);
    }
}
__device__ __forceinline__ void p1_hn(Frame& F) {
    LAS f32x4* gs = (LAS f32x4*)F.lds; LAS f32x4* sh = gs + 512;
    const int w = F.vcu, b = w >> 6; const bool writer = (w & 63) == 0;
    for (int s = F.tid; s < (writer ? 1536 : 1024); s += NWAVES * 64) {
        f32x4 a = *(const GAS f32x4*)(F.b_ada + 4 * s);
#pragma unroll 8
        for (int ks = 0; ks < 32; ++ks) a += *(const GAS f32x4*)(F.modp + (size_t)(ks * 4 + b) * 6144 + 4 * s);
        if (s < 512) sh[s] = a; else if (s < 1024) { const f32x4 nw = *(const GAS f32x4*)(F.norm_w + 4 * (s - 512)); gs[s - 512] = nw * (1.0f + a); }
        if (writer) *(GAS f32x4*)(F.mod + (size_t)b * 6144 + 4 * s) = a;
    }
    __syncthreads();
#pragma unroll 1
    for (int r = 0; r < 4; ++r) {
        const int row = 32 * w + 4 * F.wave + r;
        const GAS f32x4* xr = (const GAS f32x4*)(F.x + (size_t)row * 2048) + F.lane;
        f32x4 v[8]; float s = 0.f;
#pragma unroll
        for (int j = 0; j < 8; ++j) { v[j] = xr[64 * j]; s += (v[j].x * v[j].x + v[j].y * v[j].y) + (v[j].z * v[j].z + v[j].w * v[j].w); }
        const float rinv = 1.0f / sqrtf(wave_sum(s) * (1.0f / 2048.0f) + NORM_EPS);
        GAS unsigned long long* o8 = (GAS unsigned long long*)(F.HN + (size_t)row * 2048) + F.lane;
#pragma unroll
        for (int j = 0; j < 8; ++j) { const f32x4 g = gs[F.lane + 64 * j], sf = sh[F.lane + 64 * j]; const f32x4 y = v[j] * rinv * g + sf;
            o8[64 * j] = (unsigned long long)pk2(y.x, y.y) | ((unsigned long long)pk2(y.z, y.w) << 32); }
    }
}
__device__ __forceinline__ void p6_final(Frame& F) {
    const int gw = F.vcu * NWAVES + F.wave, NGW = F.G * NWAVES;
    for (int row = gw; row < M; row += NGW) {
        const float rinv = 1.0f / sqrtf(F.rowss[row] * (1.0f / 2048.0f) + NORM_EPS);
        GAS f32x4* xr = (GAS f32x4*)(F.out + (size_t)row * 2048) + F.lane;
#pragma unroll
        for (int j = 0; j < 8; ++j) { const f32x4 v = xr[64 * j], wv = *(const GAS f32x4*)(F.fnw + 4 * (F.lane + 64 * j)); xr[64 * j] = v * rinv * wv; }
    }
}

#ifndef REP_P0
#define REP_P0 1
#endif
#ifndef REP_P1
#define REP_P1 1
#endif
#ifndef REP_P2
#define REP_P2 1
#endif
#ifndef REP_P3
#define REP_P3 1
#endif
#ifndef REP_ATT
#define REP_ATT 1
#endif
#ifndef REP_GLA
#define REP_GLA 1
#endif
constexpr int NPH = 8;
struct Args { const float* in[16]; float* out; unsigned char* ws; int ph_lo, ph_hi, li, pad; };
__global__ void __launch_bounds__(NWAVES * 64, 2) mega_fwd(Args args) {
    extern __shared__ __attribute__((aligned(16))) unsigned char lds[];
    Frame F;
    F.lds = (LAS unsigned char*)lds; F.MISC = (volatile LAS unsigned*)(F.lds + MISC_OFF);
    F.tid = threadIdx.x; F.lane = F.tid & 63; F.wave = __builtin_amdgcn_readfirstlane(F.tid >> 6);
    F.G = gridDim.x; { const int bx = blockIdx.x; F.vcu = (F.G % 8 == 0) ? (bx % 8) * (F.G / 8) + bx / 8 : bx; }
    unsigned char* ws = args.ws;
    F.ctl = (gu32*)(ws + WS_CTL);
    F.x = args.in[0]; F.c = args.in[1]; F.norm_w = args.in[2]; F.w_ada = args.in[3]; F.b_ada = args.in[4]; F.w_in = args.in[5];
    F.lq1 = args.in[6]; F.lk1 = args.in[7]; F.lq2 = args.in[8]; F.lk2 = args.in[9]; F.dnw = args.in[10]; F.w2 = args.in[11]; F.gb = args.in[12]; F.gnw = args.in[13];
    F.w_out = args.in[14]; F.fnw = args.in[15]; F.out = args.out;
    F.modp = (float*)(ws + WS_MODP); F.mod = (float*)(ws + WS_MOD); F.rope = (float*)(ws + WS_ROPE); F.decay = (float*)(ws + WS_DECAY); F.rowss = (float*)(ws + WS_CTL) + CW_ROWSS;
    F.Win_t = (bf16*)(ws + WS_WIN); F.Wout_t = (bf16*)(ws + WS_WOUT); F.HN = (bf16*)(ws + WS_HN); F.PROJ = (bf16*)(ws + WS_PROJ); F.UT = (bf16*)(ws + WS_HN);     F.MIX = (bf16*)(ws + WS_MIX);
    for (int u = F.tid; u < (LDS_BYTES - LDSCTL_OFF) / 4; u += NWAVES * 64) ((LAS unsigned*)(F.lds + LDSCTL_OFF))[u] = 0u;
    __syncthreads();
    const int lo = args.ph_lo, hi = args.ph_hi;
    const bool use_bar = (hi - lo) > 1;
    XcdBarrier bar; bar.bar = (unsigned*)(F.ctl + CW_BAR) + args.li * XCD_BAR_WORDS; bar.x = 0; bar.st = nullptr;
    if (use_bar) bar = xcd_barrier_post((unsigned*)(F.ctl + CW_BAR) + args.li * XCD_BAR_WORDS, F.MISC + 8);
#define IN(k) (lo <= (k) && (k) < hi)
#define SEAM(k) do { if (IN(k) && IN((k) + 1)) xcd_barrier(bar); } while (0)

    if (IN(0)) { for (int rep = 0; rep < REP_P0; ++rep) p0_prologue(F); SEAM(0); }
    if (IN(1)) { for (int rep = 0; rep < REP_P1; ++rep) { p1_hn(F); __syncthreads(); } SEAM(1); }
    if (IN(2)) {
        pg8::Gemm g{F.HN, F.Win_t, M, PITCH, 2048}; pg8::StaticOrder S; S.init(M, PITCH, F.G, (int)blockIdx.x);
        pg8::EpiProj E{F.PROJ, F.rope};
        for (int rep = 0; rep < REP_P2; ++rep) pg8::gemm_phase<pg8::EpiProj, pg8::StaticOrder, true, true>(F.lds, g, S, E);
        SEAM(2);
    }
    if (IN(3)) {
        for (int rep = 0; rep < REP_P3; ++rep) for (int it = F.vcu; it < 512; it += F.G) gla::prepU_item(it, F.PROJ, F.w2, F.gb, F.UT, F.decay, (LAS char*)F.lds);
        const float lam = expf(wave_sum(F.lq1[F.lane] * F.lk1[F.lane])) - expf(wave_sum(F.lq2[F.lane] * F.lk2[F.lane])) + 0.2f;
        for (int rep = 0; rep < REP_ATT; ++rep) for (int v = F.vcu; v < 256; v += F.G) { const int bh = v >> 3, s = v & 7;
            att::attn_unit(bh >> 3, bh & 7, 15 - s, F.PROJ, F.MIX, F.dnw, lam, (LAS char*)F.lds);
            att::attn_unit(bh >> 3, bh & 7, s, F.PROJ, F.MIX, F.dnw, lam, (LAS char*)F.lds); }
        SEAM(3);
    }
    if (IN(4)) {
        for (int rep = 0; rep < REP_GLA; ++rep) for (int g = F.vcu * (NWAVES * 64) + F.tid; g < 131072; g += F.G * NWAVES * 64) gla::scan_elem(g, F.UT, F.decay);
        SEAM(4);
    }
    if (IN(5)) {
        for (int it = F.vcu; it < 512; it += F.G) gla::o_item(it, F.PROJ, F.UT, F.gnw, F.MIX, (LAS char*)F.lds);
        SEAM(5);
    }
    if (IN(6)) {
        pg8::Gemm g{F.MIX, F.Wout_t, M, 2048, 2048}; pg8::StaticOrder S; S.init(M, 2048, F.G, (int)blockIdx.x);
        pg8::EpiOut E{F.x, F.out, F.mod, F.rowss};
        pg8::gemm_phase<pg8::EpiOut, pg8::StaticOrder, true, true>(F.lds, g, S, E);
        SEAM(6);
    }
    if (IN(7)) p6_final(F);
#undef IN
#undef SEAM
}

#ifndef MK_SEQ
#define MK_SEQ {0, 8}
#endif
extern "C" void kernel_launch(void* const* d_in, const int* in_sizes, int n_in, void* d_out, int out_size, void* d_ws, size_t ws_size, hipStream_t stream) {
    static int grid = 0;
    if (grid == 0) {
        if (n_in != 16 || out_size != M * DM || ws_size < WS_END) { fprintf(stderr, "kernel_launch: unexpected problem (n_in %d, out %d, ws %zu)\n", n_in, out_size, ws_size); grid = -1; return; }
        int dev = 0, cus = 0, per_cu = 0;
        if (hipGetDevice(&dev) != hipSuccess || hipDeviceGetAttribute(&cus, hipDeviceAttributeMultiprocessorCount, dev) != hipSuccess) { grid = -1; return; }
        if (hipFuncSetAttribute((const void*)mega_fwd, hipFuncAttributeMaxDynamicSharedMemorySize, LDS_BYTES) != hipSuccess) { fprintf(stderr, "kernel_launch: hipFuncSetAttribute failed\n"); grid = -1; return; }
        if (hipOccupancyMaxActiveBlocksPerMultiprocessor(&per_cu, (const void*)mega_fwd, NWAVES * 64, LDS_BYTES) != hipSuccess || per_cu < 1) fprintf(stderr, "kernel_launch: occupancy query says %d\n", per_cu);
        (void)hipGetLastError();
        grid = cus;
    }
    if (grid < 0) return;
    (void)hipMemsetAsync((char*)d_ws + WS_CTL, 0, CTL_ZERO_BYTES, stream);
    Args a{};
    for (int i = 0; i < 16; ++i) a.in[i] = (const float*)d_in[i];
    a.out = (float*)d_out; a.ws = (unsigned char*)d_ws;
    const int seq[] = MK_SEQ; const int nl = (int)(sizeof(seq) / sizeof(int)) / 2;
    for (int li = 0; li < nl; ++li) {
        a.ph_lo = seq[2 * li]; a.ph_hi = seq[2 * li + 1]; a.li = li; a.pad = 0;
        hipLaunchKernelGGL(mega_fwd, dim3(grid), dim3(NWAVES * 64), LDS_BYTES, stream, a);
    }
}
```
